# Optimizing an MI355X kernel written in HIP

```python
import math
import jax, jax.numpy as jnp
from jax import lax
import numpy as np


D_MODEL = 1024
BATCH = 8
SEQ = 4096
DEPTH = 4

GRID_W = 64
CTX_LEN = 256
HEAD_DIM = D_MODEL // 16
MLSTM_HEADS = 4
MLSTM_W = MLSTM_HEADS * HEAD_DIM
DIFF_HEADS = 4
DIFF_DV = 2 * HEAD_DIM
DIFF_W = DIFF_HEADS * DIFF_DV
GQA_HEADS = 4
GQA_KV_HEADS = 2
GQA_W = GQA_HEADS * HEAD_DIM
D_MIX = MLSTM_W + DIFF_W + GQA_W
MLSTM_CONV_W = 5
MLSTM_CHUNK = 64
Q_BLOCK = 128
ROPE_THETA = 10000.0
D_FF = (8 * D_MODEL + 3 * 256 - 1) // (3 * 256) * 256
ALPHA = (2 * DEPTH) ** 0.25
BETA = (8 * DEPTH) ** -0.25
LN_EPS = 1e-5
SPLIT_SIZES = (MLSTM_W, MLSTM_W, MLSTM_W, MLSTM_W, 4 * MLSTM_HEADS,
               2 * DIFF_HEADS * HEAD_DIM, 2 * DIFF_HEADS * HEAD_DIM, DIFF_W,
               GQA_W, GQA_KV_HEADS * HEAD_DIM, GQA_KV_HEADS * HEAD_DIM)
IN_COLS = sum(SPLIT_SIZES)

kernel_name = 'hybrid_mlstm_diffattn_gqa_dit_block'


def _layer_norm(x, g, b):
    xf = x.astype(jnp.float32)
    mu = xf.mean(-1, keepdims=True)
    var = jnp.square(xf - mu).mean(-1, keepdims=True)
    return ((xf - mu) * lax.rsqrt(var + LN_EPS) * g + b).astype(x.dtype)


def _rms_norm(x, g):
    xf = x.astype(jnp.float32)
    return (xf * lax.rsqrt(jnp.mean(xf * xf, -1, keepdims=True) + LN_EPS) * g).astype(x.dtype)


def _rope_tables(rows):
    row = jnp.repeat(jnp.arange(rows, dtype=jnp.float32), GRID_W)
    col = jnp.tile(jnp.arange(GRID_W, dtype=jnp.float32), rows)
    n_freq = HEAD_DIM // 4
    inv = ROPE_THETA ** (-jnp.arange(n_freq, dtype=jnp.float32) / n_freq)
    ar = row[:, None] * inv
    ac = col[:, None] * inv
    ang = jnp.concatenate([ar, ar, ac, ac], axis=-1)
    return jnp.cos(ang), jnp.sin(ang)


def _rot_half(u):
    u1, u2 = jnp.split(u, 2, axis=-1)
    return jnp.concatenate([-u2, u1], axis=-1)


def _apply_rope(x, cos, sin):
    xf = x.astype(jnp.float32)
    xr, xc = jnp.split(xf, 2, axis=-1)
    rot = jnp.concatenate([_rot_half(xr), _rot_half(xc)], axis=-1)
    return (xf * cos + rot * sin).astype(x.dtype)


def _heads(a, n_heads):
    b, s, _ = a.shape
    return a.reshape(b, s, n_heads, -1).transpose(0, 2, 1, 3)


def _merge_heads(a):
    b, h, s, d = a.shape
    return a.transpose(0, 2, 1, 3).reshape(b, s, h * d)


def _split_cols(p):
    out, start = [], 0
    for size in SPLIT_SIZES:
        out.append(p[..., start:start + size])
        start += size
    return out


def _dw_conv(u, w, b):
    k, ch = w.shape
    y = lax.conv_general_dilated(u, w[:, None, :], window_strides=(1,),
                                 padding=((k // 2, k // 2),),
                                 dimension_numbers=('NWC', 'WIO', 'NWC'),
                                 feature_group_count=ch)
    return y + b


def _to_blocks(a):
    *lead, s, d = a.shape
    return jnp.moveaxis(a.reshape(*lead, s // Q_BLOCK, Q_BLOCK, d), -3, 0)


def _from_blocks(a):
    a = jnp.moveaxis(a, 0, -3)
    *lead, nb, bq, d = a.shape
    return a.reshape(*lead, nb * bq, d)


def _diff_attention(q1, q2, k1, k2, v, lam):
    scale = HEAD_DIM ** -0.5

    def block(qs):
        qa, qb = qs
        p1 = jax.nn.softmax((jnp.einsum('bhqd,bhkd->bhqk', qa, k1) * scale).astype(jnp.float32), axis=-1)
        p2 = jax.nn.softmax((jnp.einsum('bhqd,bhkd->bhqk', qb, k2) * scale).astype(jnp.float32), axis=-1)
        return jnp.einsum('bhqk,bhkv->bhqv', (p1 - lam * p2).astype(v.dtype), v)

    return _from_blocks(lax.map(block, (_to_blocks(q1), _to_blocks(q2))))


def _gqa_attention(q, k, v):
    b, hq, s, d = q.shape
    qg = q.reshape(b, GQA_KV_HEADS, hq // GQA_KV_HEADS, s, d)
    scale = d ** -0.5

    def block(qb):
        p = jax.nn.softmax((jnp.einsum('bhgqd,bhkd->bhgqk', qb, k) * scale).astype(jnp.float32), axis=-1)
        return jnp.einsum('bhgqk,bhkd->bhgqd', p.astype(v.dtype), v)

    return _from_blocks(lax.map(block, _to_blocks(qg))).reshape(b, hq, s, d)


def _mlstm_scan(q, k, v, i_pre, f_pre, state):
    b, h, s, d = q.shape
    nc = s // MLSTM_CHUNK

    def chunks(a):
        return jnp.moveaxis(a.reshape(b, h, nc, MLSTM_CHUNK, *a.shape[3:]), 2, 0)

    xs = (chunks(q.astype(jnp.float32) * d ** -0.5), chunks(k.astype(jnp.float32)),
          chunks(v.astype(jnp.float32)), chunks(i_pre), chunks(jax.nn.log_sigmoid(f_pre)))
    lower = jnp.tril(jnp.ones((MLSTM_CHUNK, MLSTM_CHUNK), dtype=bool))

    def step(carry, inp):
        c_mat, n_vec, m = carry
        qc, kc, vc, ic, lf = inp
        bcum = jnp.cumsum(lf, axis=-1)
        logw = jnp.where(lower, bcum[..., :, None] - bcum[..., None, :] + ic[..., None, :], -jnp.inf)
        inter = bcum + m[..., None]
        m_t = jnp.maximum(logw.max(-1), inter)
        w = jnp.exp(logw - m_t[..., None])
        w_prev = jnp.exp(inter - m_t)
        sw = jnp.einsum('bhtd,bhsd->bhts', qc, kc) * w
        num = jnp.einsum('bhts,bhsv->bhtv', sw, vc) + w_prev[..., None] * jnp.einsum('bhtd,bhdv->bhtv', qc, c_mat)
        den = sw.sum(-1) + w_prev * jnp.einsum('bhtd,bhd->bht', qc, n_vec)
        h_out = num / jnp.maximum(jnp.abs(den), jnp.exp(-m_t))[..., None]
        b_last = bcum[..., -1]
        logu = b_last[..., None] - bcum + ic
        m_new = jnp.maximum(b_last + m, logu.max(-1))
        decay = jnp.exp(b_last + m - m_new)
        u = jnp.exp(logu - m_new[..., None])
        c_new = decay[..., None, None] * c_mat + jnp.einsum('bhs,bhsd,bhsv->bhdv', u, kc, vc)
        n_new = decay[..., None] * n_vec + jnp.einsum('bhs,bhsd->bhd', u, kc)
        return (c_new, n_new, m_new), h_out

    state, hs = lax.scan(step, state, xs)
    return jnp.moveaxis(hs, 0, 2).reshape(b, h, s, d), state


def _mlstm_prep(mq, mk, mv, mg, conv_w, conv_b, gate_b):
    qk = jax.nn.silu(_dw_conv(jnp.concatenate([mq, mk], axis=-1), conv_w, conv_b))
    q = _heads(qk[..., :MLSTM_W], MLSTM_HEADS)
    k = _heads(qk[..., MLSTM_W:], MLSTM_HEADS)
    v = _heads(mv, MLSTM_HEADS)
    g = (mg + gate_b).astype(jnp.float32).transpose(0, 2, 1)
    i_f, i_b, f_f, f_b = jnp.split(g, 4, axis=1)
    return q, k, v, (i_f, f_f), (i_b, f_b)


def _mlstm_bidirectional(lat, ctx):
    ql, kl, vl, fwd_l, bwd_l = lat
    qc, kc, vc, fwd_c, bwd_c = ctx
    b = ql.shape[0]
    zero = (jnp.zeros((b, MLSTM_HEADS, HEAD_DIM, HEAD_DIM), jnp.float32),
            jnp.zeros((b, MLSTM_HEADS, HEAD_DIM), jnp.float32),
            jnp.zeros((b, MLSTM_HEADS), jnp.float32))
    hcf, st_f = _mlstm_scan(qc, kc, vc, fwd_c[0], fwd_c[1], zero)
    hlf, _ = _mlstm_scan(ql, kl, vl, fwd_l[0], fwd_l[1], st_f)
    rev = lambda a: jnp.flip(a, axis=2)
    hcb, st_b = _mlstm_scan(rev(qc), rev(kc), rev(vc), rev(bwd_c[0]), rev(bwd_c[1]), zero)
    hlb, _ = _mlstm_scan(rev(ql), rev(kl), rev(vl), rev(bwd_l[0]), rev(bwd_l[1]), st_b)
    return hlf + rev(hlb), hcf + rev(hcb)


def _mlstm_out(h, o, g):
    mu = h.mean(-1, keepdims=True)
    var = jnp.square(h - mu).mean(-1, keepdims=True)
    hn = (h - mu) * lax.rsqrt(var + LN_EPS)
    return (_merge_heads(hn) * g * jax.nn.sigmoid(o.astype(jnp.float32))).astype(o.dtype)


def _diff_split(a):
    b, s, _ = a.shape
    a = a.reshape(b, s, DIFF_HEADS, 2, HEAD_DIM).transpose(0, 2, 3, 1, 4)
    return a[:, :, 0], a[:, :, 1]


def _diff_out(o, g, lam_init):
    return _merge_heads(_rms_norm(o, g) * (1.0 - lam_init))


def _hybrid_mixer(p_lat, p_ctx, conv_w, conv_b, gate_b, mnorm_g, lam_vecs, lam_init,
                  dnorm_g, qn_g, kn_g, cos, sin, ctx_out):
    mq, mk, mv, mo, mg, dq, dk, dv, gq, gk, gv = _split_cols(p_lat)
    mqc, mkc, mvc, moc, mgc, dqc, dkc, dvc, gqc, gkc, gvc = _split_cols(p_ctx)
    rope = lambda a: _apply_rope(a, cos, sin)
    h_lat, h_ctx = _mlstm_bidirectional(_mlstm_prep(mq, mk, mv, mg, conv_w, conv_b, gate_b),
                                        _mlstm_prep(mqc, mkc, mvc, mgc, conv_w, conv_b, gate_b))
    a_lat = _mlstm_out(h_lat, mo, mnorm_g)
    lv = lam_vecs.astype(jnp.float32)
    lam = jnp.exp(jnp.sum(lv[0] * lv[1])) - jnp.exp(jnp.sum(lv[2] * lv[3])) + lam_init
    q1, q2 = _diff_split(dq)
    k1, k2 = _diff_split(dk)
    k1c, k2c = _diff_split(dkc)
    vd, vdc = _heads(dv, DIFF_HEADS), _heads(dvc, DIFF_HEADS)
    k1_all = jnp.concatenate([k1c, rope(k1)], axis=2)
    k2_all = jnp.concatenate([k2c, rope(k2)], axis=2)
    vd_all = jnp.concatenate([vdc, vd], axis=2)
    b_lat = _diff_out(_diff_attention(rope(q1), rope(q2), k1_all, k2_all, vd_all, lam), dnorm_g, lam_init)
    qg = rope(_rms_norm(_heads(gq, GQA_HEADS), qn_g))
    kg = rope(_rms_norm(_heads(gk, GQA_KV_HEADS), kn_g))
    kgc = _rms_norm(_heads(gkc, GQA_KV_HEADS), kn_g)
    vg, vgc = _heads(gv, GQA_KV_HEADS), _heads(gvc, GQA_KV_HEADS)
    c_lat = _merge_heads(_gqa_attention(qg, jnp.concatenate([kgc, kg], axis=2),
                                        jnp.concatenate([vgc, vg], axis=2)))
    y_lat = jnp.concatenate([a_lat, b_lat, c_lat], axis=-1)
    if not ctx_out:
        return y_lat, None
    q1c, q2c = _diff_split(dqc)
    qgc = _rms_norm(_heads(gqc, GQA_HEADS), qn_g)
    a_ctx = _mlstm_out(h_ctx, moc, mnorm_g)
    b_ctx = _diff_out(_diff_attention(q1c, q2c, k1c, k2c, vdc, lam), dnorm_g, lam_init)
    cm_ctx = _merge_heads(_gqa_attention(qgc, kgc, vgc))
    return y_lat, jnp.concatenate([a_ctx, b_ctx, cm_ctx], axis=-1)


def _swiglu(u, w_in, w_out):
    gate, up = jnp.split(u @ w_in, 2, axis=-1)
    return (jax.nn.silu(gate) * up) @ w_out


def setup_inputs(seed: int = 0) -> dict:
    key = jax.random.key(seed)
    ks = jax.random.split(key, 24)
    nrm = lambda k, shape, s: s * jax.random.normal(k, shape, jnp.float32)
    gate_i = nrm(ks[9], (DEPTH, 2 * MLSTM_HEADS), 0.1)
    gate_f = jnp.tile(jnp.linspace(3.0, 6.0, MLSTM_HEADS, dtype=jnp.float32), 2) + nrm(ks[10], (DEPTH, 2 * MLSTM_HEADS), 0.1)
    return {
        'x': nrm(ks[0], (BATCH, SEQ, D_MODEL), 1.0),
        'c': nrm(ks[1], (BATCH, D_MODEL), 1.0),
        'ctx': nrm(ks[2], (BATCH, CTX_LEN, D_MODEL), 1.0),
        'c_ctx': nrm(ks[3], (D_MODEL,), 1.0),
        'w_ada': nrm(ks[4], (DEPTH, D_MODEL, 6 * D_MODEL), 0.5 * D_MODEL ** -0.5),
        'b_ada': nrm(ks[5], (DEPTH, 6 * D_MODEL), 0.01),
        'w_in': nrm(ks[6], (DEPTH, D_MODEL, IN_COLS), D_MODEL ** -0.5),
        'mlstm_conv_w': nrm(ks[7], (DEPTH, MLSTM_CONV_W, 2 * MLSTM_W), MLSTM_CONV_W ** -0.5),
        'mlstm_conv_b': nrm(ks[8], (DEPTH, 2 * MLSTM_W), 0.01),
        'mlstm_gate_b': jnp.concatenate([gate_i, gate_f], axis=-1),
        'mlstm_norm_g': 1.0 + nrm(ks[11], (DEPTH, MLSTM_W), 0.1),
        'diff_lambda': nrm(ks[12], (DEPTH, 4, HEAD_DIM), 0.1),
        'diff_norm_g': 1.0 + nrm(ks[13], (DEPTH, DIFF_DV), 0.1),
        'gqa_q_norm_g': 1.0 + nrm(ks[14], (DEPTH, HEAD_DIM), 0.1),
        'gqa_k_norm_g': 1.0 + nrm(ks[15], (DEPTH, HEAD_DIM), 0.1),
        'w_out': nrm(ks[16], (DEPTH, D_MIX, D_MODEL), BETA * D_MIX ** -0.5),
        'ln1_g': 1.0 + nrm(ks[17], (DEPTH, D_MODEL), 0.1),
        'ln1_b': nrm(ks[18], (DEPTH, D_MODEL), 0.01),
        'w_ffn_in': nrm(ks[19], (DEPTH, D_MODEL, 2 * D_FF), D_MODEL ** -0.5),
        'w_ffn_out': nrm(ks[20], (DEPTH, D_FF, D_MODEL), BETA * D_FF ** -0.5),
        'ln2_g': 1.0 + nrm(ks[21], (DEPTH, D_MODEL), 0.1),
        'ln2_b': nrm(ks[22], (DEPTH, D_MODEL), 0.01),
    }


def reference(x, c, ctx, c_ctx, w_ada, b_ada, w_in, mlstm_conv_w, mlstm_conv_b, mlstm_gate_b,
              mlstm_norm_g, diff_lambda, diff_norm_g, gqa_q_norm_g, gqa_k_norm_g, w_out,
              ln1_g, ln1_b, w_ffn_in, w_ffn_out, ln2_g, ln2_b):
    rows = x.shape[1] // GRID_W
    cos, sin = _rope_tables(rows)
    xc = ctx
    for l in range(DEPTH):
        last = l == DEPTH - 1
        lam_init = 0.8 - 0.6 * math.exp(-0.3 * l)
        mod = jax.nn.silu(c) @ w_ada[l] + b_ada[l]
        sh1, sc1, g1, sh2, sc2, g2 = jnp.split(mod[:, None, :], 6, axis=-1)
        modc = jax.nn.silu(c_ctx) @ w_ada[l] + b_ada[l]
        sh1c, sc1c, g1c, sh2c, sc2c, g2c = jnp.split(modc, 6)
        y, yc = _hybrid_mixer((x * (1 + sc1) + sh1) @ w_in[l], (xc * (1 + sc1c) + sh1c) @ w_in[l],
                              mlstm_conv_w[l], mlstm_conv_b[l], mlstm_gate_b[l], mlstm_norm_g[l],
                              diff_lambda[l], lam_init, diff_norm_g[l], gqa_q_norm_g[l], gqa_k_norm_g[l],
                              cos, sin, not last)
        x = _layer_norm(ALPHA * x + g1 * (y @ w_out[l]), ln1_g[l], ln1_b[l])
        x = _layer_norm(ALPHA * x + g2 * _swiglu(x * (1 + sc2) + sh2, w_ffn_in[l], w_ffn_out[l]), ln2_g[l], ln2_b[l])
        if not last:
            xc = _layer_norm(ALPHA * xc + g1c * (yc @ w_out[l]), ln1_g[l], ln1_b[l])
            xc = _layer_norm(ALPHA * xc + g2c * _swiglu(xc * (1 + sc2c) + sh2c, w_ffn_in[l], w_ffn_out[l]), ln2_g[l], ln2_b[l])
    return x
```

```cpp
#include <hip/hip_runtime.h>
#include <hip/hip_cooperative_groups.h>
#include <cstdio>
#include <cstdint>
namespace cg = cooperative_groups;

#define LAS __attribute__((address_space(3)))
typedef unsigned short bf16_t;
typedef short bf16x8 __attribute__((ext_vector_type(8)));
typedef float f32x4 __attribute__((ext_vector_type(4)));
typedef float f32x16 __attribute__((ext_vector_type(16)));
typedef unsigned u32x4 __attribute__((ext_vector_type(4)));
typedef unsigned u32x2 __attribute__((ext_vector_type(2)));
typedef float f32x2_t __attribute__((ext_vector_type(2)));
typedef __bf16 bf16x2_t __attribute__((ext_vector_type(2)));

__device__ __forceinline__ unsigned pk2(float lo, float hi) { f32x2_t v = {lo, hi}; bf16x2_t b = __builtin_convertvector(v, bf16x2_t); return __builtin_bit_cast(unsigned, b); }
__device__ __forceinline__ bf16_t f2bf(float f) { return (bf16_t)(pk2(f, 0.f) & 0xffffu); }
__device__ __forceinline__ float bf2f(unsigned short h) { return __uint_as_float(((unsigned)h) << 16); }
__device__ __forceinline__ float bflo(unsigned w) { return __uint_as_float(w << 16); }
__device__ __forceinline__ float bfhi(unsigned w) { return __uint_as_float(w & 0xffff0000u); }
__device__ __forceinline__ float fast_exp2(float x) { return __builtin_amdgcn_exp2f(x); }
__device__ __forceinline__ float fast_exp(float x) { return __builtin_amdgcn_exp2f(x * 1.4426950408889634f); }
__device__ __forceinline__ float fast_rcp(float x) { return __builtin_amdgcn_rcpf(x); }
__device__ __forceinline__ float silu_f(float x) { return x * fast_rcp(1.0f + fast_exp(-x)); }
__device__ __forceinline__ float sigmoid_f(float x) { return fast_rcp(1.0f + fast_exp(-x)); }

constexpr int DM = 1024, NB = 8, SEQ = 4096, CTX = 256, DEPTH = 4, TK = SEQ + CTX;
constexpr int MLAT = NB * SEQ, MCTX = NB * CTX, MTOT = MLAT + MCTX;
constexpr int NIN = 3328, INCOLS = 3088, DFF = 2816, NF1 = 2 * DFF;
constexpr float LN_EPS = 1e-5f;
constexpr float ALPHA = 1.681792830507429f;
constexpr float QSC = 0.125f * 1.4426950408889634f;

constexpr size_t MiB = 1u << 20;
constexpr size_t WS_CTL = 0, WS_MOD = 1 * MiB, WS_WIN = 2 * MiB, WS_WOUT = 9 * MiB, WS_WF1 = 11 * MiB, WS_WF2 = 22 * MiB, WS_GATES = 28 * MiB, WS_X = 32 * MiB;
constexpr size_t WS_A = 168 * MiB;
constexpr size_t WS_PM = WS_A, WS_MVT = WS_A + 51 * MiB, WS_QD = WS_A + 68 * MiB, WS_QDC = WS_A + 100 * MiB, WS_KD = WS_A + 102 * MiB, WS_VDT = WS_A + 136 * MiB,
                 WS_QG = WS_A + 170 * MiB, WS_QGC = WS_A + 186 * MiB, WS_KG = WS_A + 187 * MiB, WS_VGT = WS_A + 196 * MiB, WS_Y = WS_A + 206 * MiB;
constexpr size_t WS_H = WS_A, WS_O1 = WS_A, WS_O2 = WS_Y, WS_WF2B = WS_Y + 68 * MiB, WS_ML = WS_WF2B + 6 * MiB, WS_WOUTB = WS_ML + 56 * MiB, WS_END = WS_WOUTB + 2 * MiB;
constexpr size_t DO_U = 0, DO_HF = 68 * MiB, DO_HB = 85 * MiB, DO_WF1B = 102 * MiB;
constexpr int MODW = 6 * DM;
constexpr int LDS_BYTES = 147456;

struct Params {
  const float *x, *c, *ctx, *c_ctx, *w_ada, *b_ada, *w_in, *conv_w, *conv_b, *gate_b, *mnorm_g, *dlam, *dnorm_g, *qn_g, *kn_g, *w_out, *ln1_g, *ln1_b, *w_f1, *w_f2, *ln2_g, *ln2_b;
  float* out; unsigned char* ws;
};
namespace pg8 {
#define PG8_LAS __attribute__((address_space(3)))
typedef unsigned short bf16_t;
typedef short bf16x8 __attribute__((ext_vector_type(8)));
typedef float f32x4 __attribute__((ext_vector_type(4)));
typedef unsigned u32x4 __attribute__((ext_vector_type(4)));
constexpr int BM = 256, BK = 64, HALF = 128, HTB = HALF * BK * 2  , STAGE_BYTES = 8 * HTB, NXCD = 8, WGM = 8;

__host__ __device__ __forceinline__ int lds_byte(int r, int c) { const int st = (r >> 4) * 2 + (c >> 5), rr = r & 15, cc = c & 31, ob = rr * 64 + cc * 2; return st * 1024 + (ob ^ (((ob >> 9) & 1) << 5)); }
__host__ __device__ __forceinline__ void stage_rc(int b, int& R, int& C) { const int st = b / 1024, sb = b % 1024, swz = sb ^ (((sb >> 9) & 1) << 5); R = (st >> 1) * 16 + swz / 64; C = (st & 1) * 32 + (swz % 64) / 2; }
__host__ __device__ __forceinline__ int perm32(int rho) { const int n = rho >> 4, i = rho & 15; return 8 * (i >> 2) + 4 * n + (i & 3); }

struct Unit { int pm, pn; };
struct Gemm { const bf16_t* A; const bf16_t* Bt; int M, N, K; };

struct StaticOrder {
    int nM, nN, nwg, G, c;
    __host__ __device__ void init(int M, int N, int G_, int c_) { nM = M / BM; nN = N / BM; nwg = nM * nN; G = G_; c = c_; }
    __host__ __device__ bool next(int i, Unit& u) const {
        const long L = (long)i * G + c; if (L >= nwg) return false;
        int wgid = (int)L; { const int q = nwg / NXCD, r = nwg % NXCD, xcd = wgid % NXCD, off = wgid / NXCD; wgid = (xcd < r ? xcd * (q + 1) : r * (q + 1) + (xcd - r) * q) + off; }
        const int nig = WGM * nN, gid = wgid / nig, fm = gid * WGM, gsz = (nM - fm) < WGM ? (nM - fm) : WGM;
        u.pm = fm + ((wgid % nig) % gsz); u.pn = (wgid % nig) / gsz; return true;
    }
    __device__ __forceinline__ void a_ready(const Unit&) const {}
    __device__ __forceinline__ void done(const Unit&) const {}
};

struct EpiPlain {
    static constexpr bool PERM = true, AFTER_DRAIN = false;
    bf16_t* O; int ldc;
    __device__ __forceinline__ void operator()(const f32x4 (&acc)[2][2][4][2], const Unit& u, int wr, int wc, int fr, int fq) const {
        const int row0 = u.pm * BM + wr * 64 + fr, col0 = u.pn * BM + wc * 32 + 8 * fq;
#pragma unroll
        for (int ai = 0; ai < 2; ++ai)
#pragma unroll
            for (int m = 0; m < 4; ++m) { bf16_t* rowp = O + (size_t)(row0 + ai * HALF + m * 16) * ldc + col0;
#pragma unroll
                for (int bj = 0; bj < 2; ++bj) { const f32x4 v0 = acc[ai][bj][m][0], v1 = acc[ai][bj][m][1];
                    u32x4 w; w.x = ::pk2(v0[0], v0[1]); w.y = ::pk2(v0[2], v0[3]); w.z = ::pk2(v1[0], v1[1]); w.w = ::pk2(v1[2], v1[3]);
                    *(u32x4*)(rowp + bj * HALF) = w; } }
    }
};
struct EpiSwiglu {
    static constexpr bool PERM = true, AFTER_DRAIN = false;
    bf16_t* H;
    __device__ __forceinline__ void operator()(const f32x4 (&acc)[2][2][4][2], const Unit& u, int wr, int wc, int fr, int fq) const {
        const int row0 = u.pm * BM + wr * 64 + fr, col0 = u.pn * 128 + wc * 32 + 8 * fq;
#pragma unroll
        for (int ai = 0; ai < 2; ++ai)
#pragma unroll
            for (int m = 0; m < 4; ++m) { bf16_t* rowp = H + (size_t)(row0 + ai * HALF + m * 16) * ::DFF + col0;
                const f32x4 g0 = acc[ai][0][m][0], g1 = acc[ai][0][m][1], u0 = acc[ai][1][m][0], u1 = acc[ai][1][m][1];
                float h[8];
#pragma unroll
                for (int e = 0; e < 4; ++e) { h[e] = ::silu_f(g0[e]) * u0[e]; h[4 + e] = ::silu_f(g1[e]) * u1[e]; }
                u32x4 w; w.x = ::pk2(h[0], h[1]); w.y = ::pk2(h[2], h[3]); w.z = ::pk2(h[4], h[5]); w.w = ::pk2(h[6], h[7]);
                *(u32x4*)rowp = w; }
    }
};
struct EpiIn {
    static constexpr bool PERM = true, AFTER_DRAIN = false;
    bf16_t *Pm, *MVt, *Qd, *Qdc, *Kd, *VdT, *Qg, *Qgc, *Kg, *VgT; float* G; const float *gate_b, *qn_g, *kn_g;
    __device__ __forceinline__ void operator()(const f32x4 (&acc)[2][2][4][2], const Unit& u, int wr, int wc, int fr, int fq) const {
        const int ch = u.pn * 4 + wc;
        if (ch > 48) return;
        const bool is_ctx = u.pm >= 128;
        const int b = is_ctx ? (u.pm - 128) : (u.pm >> 4);
        int tbase = (is_ctx ? 0 : (u.pm & 15) * 256) + wr * 64 + fr;
        asm volatile("" : "+v"(tbase));
        const int rowbase = u.pm * BM + wr * 64 + fr;
        if (ch == 48) {
            const f32x4 gb = *(const f32x4*)(gate_b + 4 * fq);
#pragma unroll
            for (int ai = 0; ai < 2; ++ai)
#pragma unroll
                for (int m = 0; m < 4; ++m) *(f32x4*)(G + (size_t)(rowbase + ai * HALF + m * 16) * 16 + 4 * fq) = acc[ai][0][m][0] + gb;
            return;
        }
        if (ch < 8 || (ch >= 12 && ch < 16)) {
            const int cb = (ch < 8 ? ch * 64 : 512 + (ch - 12) * 64) + 4 * fq;
#pragma unroll
            for (int ai = 0; ai < 2; ++ai)
#pragma unroll
                for (int m = 0; m < 4; ++m) { bf16_t* rp = Pm + (size_t)(rowbase + ai * HALF + m * 16) * 768 + cb;
#pragma unroll
                    for (int bj = 0; bj < 2; ++bj)
#pragma unroll
                        for (int n = 0; n < 2; ++n) { const f32x4 v = acc[ai][bj][m][n]; u32x2 w; w.x = ::pk2(v[0], v[1]); w.y = ::pk2(v[2], v[3]); *(u32x2*)(rp + 32 * bj + 16 * n) = w; } }
            return;
        }
        if ((ch >= 8 && ch < 12) || (ch >= 32 && ch < 40) || ch >= 46) {
            bf16_t* base; int doff = 0;
            if (ch < 12) base = MVt + (size_t)(b * 4 + (ch - 8)) * 64 * ::TK;
            else if (ch < 40) { const int c8 = ch - 32; base = VdT + (size_t)(b * 4 + (c8 >> 1)) * 128 * ::TK; doff = 64 * (c8 & 1); }
            else base = VgT + (size_t)(b * 2 + (ch - 46)) * 64 * ::TK;
            const int tc0 = (is_ctx ? 0 : ::CTX) + tbase;
#pragma unroll
            for (int ai = 0; ai < 2; ++ai)
#pragma unroll
                for (int m = 0; m < 4; ++m) { const int tc = tc0 + ai * HALF + m * 16;
#pragma unroll
                    for (int bj = 0; bj < 2; ++bj)
#pragma unroll
                        for (int n = 0; n < 2; ++n) { const f32x4 v = acc[ai][bj][m][n];
#pragma unroll
                            for (int e = 0; e < 4; ++e) base[(size_t)(doff + 32 * bj + 16 * n + 4 * fq + e) * ::TK + tc] = ::f2bf(v[e]); }
                    __builtin_amdgcn_sched_barrier(0); }
            return;
        }
        const bool is_q = (ch < 24) || (ch >= 40 && ch < 44);
        const bool do_norm = ch >= 40;
        bf16_t* base; int toff = 0;
        if (ch < 24) { const int c8 = ch - 16; if (is_ctx) { base = Qdc + (size_t)(b * 8 + c8) * ::CTX * 64; } else { base = Qd + (size_t)(b * 8 + c8) * ::SEQ * 64; } }
        else if (ch < 32) { const int c8 = ch - 24; base = Kd + (size_t)(b * 8 + c8) * ::TK * 64; toff = is_ctx ? 0 : ::CTX; }
        else if (ch < 44) { const int hq = ch - 40; if (is_ctx) { base = Qgc + (size_t)(b * 4 + hq) * ::CTX * 64; } else { base = Qg + (size_t)(b * 4 + hq) * ::SEQ * 64; } }
        else { const int kvh = ch - 44; base = Kg + (size_t)(b * 2 + kvh) * ::TK * 64; toff = is_ctx ? 0 : ::CTX; }
        float invf[4];
#pragma unroll
        for (int e = 0; e < 4; ++e) invf[e] = ::fast_exp2(-(float)(4 * fq + e) * (13.287712379549449f / 16.0f));
        const float* gn = ((ch < 44) ? qn_g : kn_g) + 4 * fq;
        const float osc = is_q ? ::QSC : 1.0f;
#pragma unroll
        for (int ai = 0; ai < 2; ++ai)
#pragma unroll
            for (int m = 0; m < 4; ++m) {
                const int t = tbase + ai * HALF + m * 16;
                float r = osc;
                if (do_norm) {
                    float ss = 0.f;
#pragma unroll
                    for (int bj = 0; bj < 2; ++bj)
#pragma unroll
                        for (int n = 0; n < 2; ++n)
#pragma unroll
                            for (int e = 0; e < 4; ++e) ss += acc[ai][bj][m][n][e] * acc[ai][bj][m][n][e];
                    ss += __shfl_xor(ss, 16); ss += __shfl_xor(ss, 32);
                    r *= __builtin_amdgcn_rsqf(ss * (1.0f / 64.0f) + ::LN_EPS);
                }
                bf16_t* rp = base + (size_t)(toff + t) * 64 + 4 * fq;
#pragma unroll
                for (int bj = 0; bj < 2; ++bj) {
                    f32x4 lo = acc[ai][bj][m][0] * r, hi2 = acc[ai][bj][m][1] * r;
                    if (do_norm) { lo = lo * *(const f32x4*)(gn + 32 * bj); hi2 = hi2 * *(const f32x4*)(gn + 32 * bj + 16); }
                    if (!is_ctx) {
                        const float pos = bj == 0 ? (float)(t >> 6) : (float)(t & 63);
#pragma unroll
                        for (int e = 0; e < 4; ++e) { const float th = pos * invf[e]; const float cs = __cosf(th), sn = __sinf(th);
                            const float a = lo[e], bq = hi2[e]; lo[e] = a * cs - bq * sn; hi2[e] = bq * cs + a * sn; }
                    }
                    u32x2 w; w.x = ::pk2(lo[0], lo[1]); w.y = ::pk2(lo[2], lo[3]); *(u32x2*)(rp + 32 * bj) = w;
                    w.x = ::pk2(hi2[0], hi2[1]); w.y = ::pk2(hi2[2], hi2[3]); *(u32x2*)(rp + 32 * bj + 16) = w;
                    __builtin_amdgcn_sched_barrier(0);
                }
            }
    }
};

struct SingleOrder {
    int pm, pn; unsigned* cnt;
    __device__ bool next(int i, Unit& u) const { if (i > 0) return false; u.pm = pm; u.pn = pn; return true; }
    __device__ __forceinline__ void a_ready(const Unit&) const {}
    __device__ __forceinline__ void done(const Unit&) const { __builtin_amdgcn_fence(__ATOMIC_RELEASE, "agent"); if ((threadIdx.x & 63) == 0) __hip_atomic_fetch_add(cnt, 1u, __ATOMIC_RELAXED, __HIP_MEMORY_SCOPE_AGENT); }
};
template <class Epi, class Sched, bool ALIGN_EPI = false, bool SP2 = false>
__device__ __forceinline__ void gemm_phase(PG8_LAS unsigned char* lds, const Gemm g, const Sched& S, const Epi& E) {
    int tid_ = threadIdx.x; asm volatile("" : "+v"(tid_));
    const int tid = tid_, wid = __builtin_amdgcn_readfirstlane(tid >> 6), lane = tid & 63, wr = wid >> 2, wc = wid & 3, fr = lane & 15, fq = lane >> 4;
    const int K = g.K, nt = K / BK;
    unsigned voffA[2], voffB[2];
#pragma unroll
    for (int i = 0; i < 2; ++i) { int R, C; stage_rc(tid * 16 + i * 8192, R, C); const int Rb = Epi::PERM ? ((R & ~31) + perm32(R & 31)) : R;
        voffA[i] = (unsigned)(R * K + C) * 2u; voffB[i] = (unsigned)(Rb * K + C) * 2u; }
    const size_t kstep = (size_t)(BK * 2);
    const size_t hstep = (size_t)HALF * K * 2;
    const size_t tstep = 2 * hstep;
    const unsigned ldsw = (unsigned)wid * 1024u;
    const int aoff = lds_byte(wr * 64 + fr, fq * 8), boff = lds_byte(wc * 32 + fr, fq * 8);
#define PG8_SA(b, h) (((b) * 2 + (h)) * HTB)
#define PG8_SB(b, h) ((4 + (b) * 2 + (h)) * HTB)
#define PG8_STAGE(bufoff, gbase, voff) do { _Pragma("unroll") for (int _i = 0; _i < 2; ++_i) \
        __builtin_amdgcn_global_load_lds((const unsigned*)((const char*)(gbase) + (voff)[_i]), (PG8_LAS unsigned*)(lds + (bufoff) + ldsw + _i * 8192), 16, 0, 0); } while (0)
#define PG8_LDA(dst, b, h) do { _Pragma("unroll") for (int m = 0; m < 4; ++m) _Pragma("unroll") for (int k = 0; k < 2; ++k) dst[m][k] = *(const PG8_LAS bf16x8*)(lds + PG8_SA(b, h) + aoff + m * 2048 + k * 1024); } while (0)
#define PG8_LDB(dst, b, h) do { _Pragma("unroll") for (int n = 0; n < 2; ++n) _Pragma("unroll") for (int k = 0; k < 2; ++k) dst[n][k] = *(const PG8_LAS bf16x8*)(lds + PG8_SB(b, h) + boff + n * 2048 + k * 1024); } while (0)
#define PG8_MMA(ai, bj, At, Bt) do { __builtin_amdgcn_s_setprio(1); _Pragma("unroll") for (int m = 0; m < 4; ++m) _Pragma("unroll") for (int n = 0; n < 2; ++n) _Pragma("unroll") for (int k = 0; k < 2; ++k) \
        acc[ai][bj][m][n] = __builtin_amdgcn_mfma_f32_16x16x32_bf16(Bt[n][k], At[m][k], acc[ai][bj][m][n], 0, 0, 0); __builtin_amdgcn_s_setprio(0); } while (0)
#define PG8_WAIT_V(n) asm volatile("s_waitcnt vmcnt(" #n ")" ::: "memory")
#define PG8_WAIT_L(n) asm volatile("s_waitcnt lgkmcnt(" #n ")" ::: "memory")
#define PG8_BAR __builtin_amdgcn_s_barrier()
#define PG8_SCHED __builtin_amdgcn_sched_barrier(0)
    Unit cur, nxt; int ui = 0;
    if (!S.next(0, cur)) return;
    f32x4 acc[2][2][4][2];
#pragma unroll
    for (int a = 0; a < 2; ++a)
#pragma unroll
        for (int b = 0; b < 2; ++b)
#pragma unroll
            for (int m = 0; m < 4; ++m)
#pragma unroll
                for (int n = 0; n < 2; ++n) acc[a][b][m][n] = (f32x4){0.f, 0.f, 0.f, 0.f};
    bf16x8 At[4][2], B0[2][2], B1[2][2];
    const char* cA = (const char*)g.A + (size_t)cur.pm * tstep; const char* cB = (const char*)g.Bt + (size_t)cur.pn * tstep;
    S.a_ready(cur);
    if constexpr (SP2) {
        PG8_STAGE(PG8_SB(0, 0), cB, voffB); PG8_STAGE(PG8_SB(0, 1), cB + hstep, voffB); PG8_STAGE(PG8_SA(0, 0), cA, voffA); PG8_STAGE(PG8_SA(0, 1), cA + hstep, voffA);
        if (wr == 1) PG8_BAR;
        PG8_WAIT_V(2); PG8_BAR;
        PG8_STAGE(PG8_SB(1, 0), cB + kstep, voffB); PG8_STAGE(PG8_SA(1, 0), cA + kstep, voffA); PG8_STAGE(PG8_SB(1, 1), cB + hstep + kstep, voffB);
        PG8_WAIT_V(6); PG8_BAR;
    } else {
        PG8_STAGE(PG8_SB(0, 0), cB, voffB); PG8_STAGE(PG8_SA(0, 0), cA, voffA); PG8_STAGE(PG8_SB(0, 1), cB + hstep, voffB); PG8_STAGE(PG8_SA(0, 1), cA + hstep, voffA);
        if (wr == 1) PG8_BAR;
        PG8_WAIT_V(4); PG8_BAR;
        PG8_STAGE(PG8_SB(1, 0), cB + kstep, voffB); PG8_STAGE(PG8_SA(1, 0), cA + kstep, voffA); PG8_STAGE(PG8_SB(1, 1), cB + hstep + kstep, voffB);
        PG8_WAIT_V(6); PG8_BAR;
    }
    for (;;) {
        const bool has_next = S.next(ui + 1, nxt);
        const char* nA = has_next ? (const char*)g.A + (size_t)nxt.pm * tstep : cA; const char* nB = has_next ? (const char*)g.Bt + (size_t)nxt.pn * tstep : cB;
        for (int t = 0; t < nt; t += 2) {
            const bool last = (t == nt - 2);
            const char* a1 = cA + (size_t)(t + 1) * kstep;
            const char* a2 = last ? nA : cA + (size_t)(t + 2) * kstep; const char* b2 = last ? nB : cB + (size_t)(t + 2) * kstep;
            const char* a3 = a2 + kstep; const char* b3 = b2 + kstep;
            if (last && has_next) S.a_ready(nxt);
            if constexpr (SP2) {
            PG8_LDB(B0, 0, 0); PG8_LDB(B1, 0, 1); PG8_SCHED; PG8_LDA(At, 0, 0); PG8_STAGE(PG8_SA(1, 1), a1 + hstep, voffA);
            PG8_WAIT_V(8); PG8_WAIT_L(0); PG8_BAR; PG8_MMA(0, 0, At, B0); PG8_MMA(0, 1, At, B1); PG8_BAR; PG8_SCHED;
            PG8_LDA(At, 0, 1); PG8_STAGE(PG8_SB(0, 0), b2, voffB); PG8_STAGE(PG8_SB(0, 1), b2 + hstep, voffB); PG8_STAGE(PG8_SA(0, 0), a2, voffA);
            PG8_WAIT_V(8); PG8_WAIT_L(0); PG8_BAR; PG8_MMA(1, 0, At, B0); PG8_MMA(1, 1, At, B1); PG8_BAR; PG8_SCHED;
            PG8_LDB(B0, 1, 0); PG8_LDB(B1, 1, 1); PG8_SCHED; PG8_LDA(At, 1, 0); PG8_STAGE(PG8_SA(0, 1), a2 + hstep, voffA);
            PG8_WAIT_V(8); PG8_WAIT_L(0); PG8_BAR; PG8_MMA(0, 0, At, B0); PG8_MMA(0, 1, At, B1); PG8_BAR; PG8_SCHED;
            PG8_LDA(At, 1, 1); PG8_STAGE(PG8_SB(1, 0), b3, voffB); PG8_STAGE(PG8_SB(1, 1), b3 + hstep, voffB); PG8_STAGE(PG8_SA(1, 0), a3, voffA);
            PG8_WAIT_V(8); PG8_WAIT_L(0); PG8_BAR; PG8_MMA(1, 0, At, B0); PG8_MMA(1, 1, At, B1); PG8_BAR; PG8_SCHED;
            } else {
            PG8_LDB(B0, 0, 0); PG8_SCHED; PG8_LDA(At, 0, 0); PG8_STAGE(PG8_SA(1, 1), a1 + hstep, voffA);
            PG8_WAIT_L(8); PG8_BAR; PG8_WAIT_L(0); PG8_MMA(0, 0, At, B0); PG8_BAR; PG8_SCHED;
            PG8_LDB(B1, 0, 1); PG8_STAGE(PG8_SB(0, 0), b2, voffB);
            PG8_BAR; PG8_WAIT_L(0); PG8_MMA(0, 1, At, B1); PG8_BAR;
            PG8_LDA(At, 0, 1); PG8_STAGE(PG8_SA(0, 0), a2, voffA);
            PG8_BAR; PG8_WAIT_L(0); PG8_MMA(1, 0, At, B0); PG8_BAR; PG8_SCHED;
            PG8_STAGE(PG8_SB(0, 1), b2 + hstep, voffB);
            PG8_WAIT_V(6); PG8_BAR; PG8_MMA(1, 1, At, B1); PG8_BAR;
            PG8_LDB(B0, 1, 0); PG8_SCHED; PG8_LDA(At, 1, 0); PG8_STAGE(PG8_SA(0, 1), a2 + hstep, voffA);
            PG8_WAIT_L(8); PG8_BAR; PG8_WAIT_L(0); PG8_MMA(0, 0, At, B0); PG8_BAR; PG8_SCHED;
            PG8_LDB(B1, 1, 1); PG8_STAGE(PG8_SB(1, 0), b3, voffB);
            PG8_BAR; PG8_WAIT_L(0); PG8_MMA(0, 1, At, B1); PG8_BAR;
            PG8_LDA(At, 1, 1); PG8_STAGE(PG8_SA(1, 0), a3, voffA);
            PG8_BAR; PG8_WAIT_L(0); PG8_MMA(1, 0, At, B0); PG8_BAR; PG8_SCHED;
            PG8_STAGE(PG8_SB(1, 1), b3 + hstep, voffB);
            PG8_WAIT_V(6); PG8_BAR; PG8_MMA(1, 1, At, B1); PG8_BAR;
            }
        }
        if constexpr (ALIGN_EPI) { if (wr == 0) PG8_BAR; }
        if constexpr (!Epi::AFTER_DRAIN) { E(acc, cur, wr, wc, fr, fq); S.done(cur); }
        if (!has_next) break;
#pragma unroll
        for (int a = 0; a < 2; ++a)
#pragma unroll
            for (int b = 0; b < 2; ++b)
#pragma unroll
                for (int m = 0; m < 4; ++m)
#pragma unroll
                    for (int n = 0; n < 2; ++n) acc[a][b][m][n] = (f32x4){0.f, 0.f, 0.f, 0.f};
        cur = nxt; cA = nA; cB = nB; ++ui;
        if constexpr (ALIGN_EPI) { if (wr == 1) PG8_BAR; }
    }
    PG8_WAIT_V(0);
    if constexpr (!ALIGN_EPI) { if (wr == 0) PG8_BAR; }
    PG8_BAR;
    if constexpr (Epi::AFTER_DRAIN) { E.fused(acc, cur, wr, wc, fr, fq, lds, wid, lane); S.done(cur); }
#undef PG8_SA
#undef PG8_SB
#undef PG8_STAGE
#undef PG8_LDA
#undef PG8_LDB
#undef PG8_MMA
#undef PG8_WAIT_V
#undef PG8_WAIT_L
#undef PG8_BAR
#undef PG8_SCHED
}
}
#define XB_TMO      128
#define XB_XCNT(j)  (256  + 64 * (j))
#define XB_XSUB(j)  (1280 + 64 * (j))
#define XB_XGEN(j)  (2304 + 64 * (j))
#define XB_TOP      3328
#define XB_TOPGEN   3392
#define XCD_BAR_WORDS 3456
#define XB_SPIN_CAP (1u << 18)

__device__ __forceinline__ unsigned xb_ld(unsigned* p)              { return __hip_atomic_load(p, __ATOMIC_RELAXED, __HIP_MEMORY_SCOPE_AGENT); }
__device__ __forceinline__ unsigned xb_add(unsigned* p, unsigned v) { return __hip_atomic_fetch_add(p, v, __ATOMIC_RELAXED, __HIP_MEMORY_SCOPE_AGENT); }
__device__ __forceinline__ unsigned xb_xcc_id() { return (unsigned)__builtin_amdgcn_s_getreg((3 << 11) | 20) & 0xFu; }
#define XB_SPIN(cond, bar) do { unsigned _sp = 0; while (cond) { __builtin_amdgcn_s_sleep(1); \
    if ((++_sp & 255u) == 0u) { if (xb_ld(&(bar)[XB_TMO])) break; if (_sp > XB_SPIN_CAP) { atomicAdd(&(bar)[XB_TMO], 1u); break; } } } } while (0)

struct XcdBarrier {
    unsigned* bar; unsigned x;
    volatile LAS unsigned* st;
};

__device__ __forceinline__ XcdBarrier xcd_barrier_post(unsigned* bar, volatile LAS unsigned* st) {
    XcdBarrier b; b.bar = bar; b.x = xb_xcc_id(); b.st = st;
    if (threadIdx.x == 0) (void)xb_add(&bar[XB_XCNT(b.x)], 1u);
    return b;
}
__device__ __forceinline__ void xcd_barrier_complete(unsigned* bar, unsigned x, unsigned& nloc, unsigned& nx) {
    const unsigned G = gridDim.x * gridDim.y * gridDim.z;
    unsigned sum, cnt, mine, sp = 0u;
    for (;;) {
        sum = 0u; cnt = 0u; mine = 0u;
#pragma unroll
        for (unsigned j = 0; j < 16; ++j) { const unsigned c = xb_ld(&bar[XB_XCNT(j)]); sum += c; cnt += (c > 0u) ? 1u : 0u; mine = (j == x) ? c : mine; }
        if (sum == G) break;
        __builtin_amdgcn_s_sleep(1);
        if ((++sp & 255u) == 0u) { if (xb_ld(&bar[XB_TMO])) break; if (sp > XB_SPIN_CAP) { atomicAdd(&bar[XB_TMO], 1u); break; } }
    }
    nloc = mine > 0u ? mine : 1u; nx = cnt > 0u ? cnt : 1u;
}

__device__ __forceinline__ void xcd_barrier(const XcdBarrier& b_in) {
    XcdBarrier b = b_in; { unsigned xx_ = (unsigned)__builtin_amdgcn_readfirstlane((int)b.x); asm volatile("" : "+s"(xx_)); b.x = xx_; }
    asm volatile("s_waitcnt vmcnt(0)" ::: "memory");
    __syncthreads();
    if (threadIdx.x == 0) {
        unsigned* bar = b.bar;
        __builtin_amdgcn_s_waitcnt(0);
        unsigned nloc = b.st[0], nx = b.st[1];
        if (nloc == 0u) { xcd_barrier_complete(bar, b.x, nloc, nx); b.st[0] = nloc; b.st[1] = nx; }
        const unsigned old = xb_add(&bar[XB_XSUB(b.x)], 1u);
        const unsigned gen = old / nloc;
        if (old + 1u == (gen + 1u) * nloc) {
            __builtin_amdgcn_fence(__ATOMIC_RELEASE, "agent");
            asm volatile("s_waitcnt vmcnt(0)" ::: "memory");
            const unsigned og = xb_add(&bar[XB_TOP], 1u);
            const unsigned tg = og / nx;
            if (og + 1u == (tg + 1u) * nx) xb_add(&bar[XB_TOPGEN], 1u);
            else XB_SPIN(xb_ld(&bar[XB_TOPGEN]) == tg, bar);
            __builtin_amdgcn_fence(__ATOMIC_ACQUIRE, "agent");
            xb_add(&bar[XB_XGEN(b.x)], 1u);
            asm volatile("s_waitcnt vmcnt(0)" ::: "memory");
        } else {
            XB_SPIN(xb_ld(&bar[XB_XGEN(b.x)]) == gen, bar);
            __builtin_amdgcn_fence(__ATOMIC_ACQUIRE, "agent");
            asm volatile("s_waitcnt vmcnt(0)" ::: "memory");
        }
    }
    __syncthreads();
}

__device__ __forceinline__ float wave_sum(float v) {
#pragma unroll
    for (int o = 1; o < 64; o <<= 1) v += __shfl_xor(v, o);
    return v;
}
__device__ __forceinline__ int win_col(int p) {
    const int pn = p >> 8, q = p & 255, bj = q >> 7, wc = (q >> 5) & 3, x = q & 31, n = (x >> 2) & 1, fq = x >> 3, e = x & 3;
    const int delta = 32 * bj + 16 * n + 4 * fq + e, ch = 4 * pn + wc;
    if (ch < 16) return ch * 64 + delta;
    if (ch < 48) return 1040 + (ch - 16) * 64 + delta;
    if (ch == 48 && delta < 16) return 1024 + delta;
    return -1;
}
__device__ __forceinline__ int wf1_col(int p) {
    const int pn = p >> 8, q = p & 255, bj = q >> 7, r = q & 127;
    return bj * DFF + 128 * pn + r;
}
struct WcItem { const float* W; bf16_t* Wt; int K, Nlog, k0, n0, mode; };
__device__ __forceinline__ WcItem wc_decode(const Params& p, int l, int which, int it) {
    constexpr int I0 = 16 * (NIN / 64), I1 = 16 * 16, I2 = 16 * (NF1 / 64);
    const int n0 = (which & 1) ? I0 : 0, n1 = (which & 2) ? I1 : 0, n2 = (which & 4) ? I2 : 0;
    WcItem w; int r = it, ntn;
    if (r < n0) { w.W = p.w_in + (size_t)l * DM * INCOLS; w.Wt = (bf16_t*)(p.ws + WS_WIN); w.K = DM; w.Nlog = INCOLS; ntn = NIN / 64; w.mode = 0; }
    else if ((r -= n0) < n1) { w.W = p.w_out + (size_t)l * DM * DM; w.Wt = (bf16_t*)(p.ws + ((l & 1) ? WS_WOUTB : WS_WOUT)); w.K = DM; w.Nlog = DM; ntn = 16; w.mode = 1; }
    else if ((r -= n1) < n2) { w.W = p.w_f1 + (size_t)l * DM * NF1; w.Wt = (l & 1) ? (bf16_t*)((unsigned char*)p.out + DO_WF1B) : (bf16_t*)(p.ws + WS_WF1); w.K = DM; w.Nlog = NF1; ntn = NF1 / 64; w.mode = 2; }
    else { r -= n2; w.W = p.w_f2 + (size_t)l * DFF * DM; w.Wt = (bf16_t*)(p.ws + ((l & 1) ? WS_WF2B : WS_WF2)); w.K = DFF; w.Nlog = DM; ntn = 16; w.mode = 1; }
    w.k0 = (r / ntn) * 64; w.n0 = (r % ntn) * 64;
    return w;
}
__device__ __forceinline__ void wc_load(const WcItem& w, int tid, float (&v)[8]) {
    const int nn = tid & 63, kk = tid >> 6, pcol = w.n0 + nn;
    const int col = w.mode == 0 ? win_col(pcol) : (w.mode == 2 ? wf1_col(pcol) : pcol);
    const float* src = w.W + (size_t)(w.k0 + kk) * w.Nlog + (col >= 0 ? col : 0);
#pragma unroll
    for (int i = 0; i < 8; ++i) { const float x = src[(size_t)(8 * i) * w.Nlog]; v[i] = col >= 0 ? x : 0.f; }
}
__device__ __forceinline__ void wconv_phase(const Params& p, int l, int which, LAS unsigned char* lds) {
    constexpr int I0 = 16 * (NIN / 64), I1 = 16 * 16, I2 = 16 * (NF1 / 64), I3 = (DFF / 64) * 16;
    const int tot = ((which & 1) ? I0 : 0) + ((which & 2) ? I1 : 0) + ((which & 4) ? I2 : 0) + ((which & 8) ? I3 : 0);
    int tid_ = threadIdx.x; asm volatile("" : "+v"(tid_));
    const int tid = tid_;
    LAS float* tl = (LAS float*)lds;
    int it = blockIdx.x;
    if (it >= tot) return;
    WcItem cur = wc_decode(p, l, which, it);
    float v[8]; wc_load(cur, tid, v);
    for (;;) {
        const int nxt = it + gridDim.x; const bool has = nxt < tot;
        WcItem nw = cur; float vn[8];
        if (has) { nw = wc_decode(p, l, which, nxt); wc_load(nw, tid, vn); }
        { const int nn = tid & 63, kk = tid >> 6;
#pragma unroll
          for (int i = 0; i < 8; ++i) tl[(kk + 8 * i) * 65 + nn] = v[i]; }
        __syncthreads();
        { const int n = tid >> 3, c = tid & 7; const LAS float* s = tl + (8 * c) * 65 + n;
          u32x4 o; o.x = pk2(s[0], s[65]); o.y = pk2(s[2 * 65], s[3 * 65]); o.z = pk2(s[4 * 65], s[5 * 65]); o.w = pk2(s[6 * 65], s[7 * 65]);
          *(u32x4*)(cur.Wt + (size_t)(cur.n0 + n) * cur.K + cur.k0 + 8 * c) = o; }
        __syncthreads();
        if (!has) break;
        it = nxt; cur = nw;
#pragma unroll
        for (int i = 0; i < 8; ++i) v[i] = vn[i];
    }
}
__device__ __forceinline__ void wconv_dyn(const Params& p, int l, int which, unsigned* ctr, LAS unsigned char* lds) {
    constexpr int I0 = 16 * (NIN / 64), I1 = 16 * 16, I2 = 16 * (NF1 / 64), I3 = (DFF / 64) * 16;
    const int tot = ((which & 1) ? I0 : 0) + ((which & 2) ? I1 : 0) + ((which & 4) ? I2 : 0) + ((which & 8) ? I3 : 0);
    int tid_ = threadIdx.x; asm volatile("" : "+v"(tid_));
    const int tid = tid_;
    LAS float* tl = (LAS float*)lds;
    LAS int* slot = (LAS int*)(lds + LDS_BYTES - 16);
    for (;;) {
        if (tid == 0) *slot = (int)atomicAdd(ctr, 1u);
        __syncthreads();
        const int it = *slot;
        __syncthreads();
        if (it >= tot) break;
        const WcItem cur = wc_decode(p, l, which, it);
        float v[8]; wc_load(cur, tid, v);
        { const int nn = tid & 63, kk = tid >> 6;
#pragma unroll
          for (int i = 0; i < 8; ++i) tl[(kk + 8 * i) * 65 + nn] = v[i]; }
        __syncthreads();
        { const int n = tid >> 3, c = tid & 7; const LAS float* s = tl + (8 * c) * 65 + n;
          u32x4 o; o.x = pk2(s[0], s[65]); o.y = pk2(s[2 * 65], s[3 * 65]); o.z = pk2(s[4 * 65], s[5 * 65]); o.w = pk2(s[6 * 65], s[7 * 65]);
          *(u32x4*)(cur.Wt + (size_t)(cur.n0 + n) * cur.K + cur.k0 + 8 * c) = o; }
        __syncthreads();
    }
}
__device__ __forceinline__ void mod_phase(const Params& p, LAS unsigned char* lds) {
    LAS float* sc = (LAS float*)lds;
    LAS float* red = (LAS float*)(lds + 9 * 1024 * 4);
    float* mod = (float*)(p.ws + WS_MOD);
    int tid_ = threadIdx.x; asm volatile("" : "+v"(tid_));
    const int tid = tid_;
    constexpr int NIT = DEPTH * (MODW / 64);
    if ((int)blockIdx.x < NIT) {
        for (int i = tid; i < 9 * 1024; i += 512) { const float v = i < 8192 ? p.c[i] : p.c_ctx[i - 8192]; sc[i] = v / (1.0f + expf(-v)); }
        __syncthreads();
        for (int it = blockIdx.x; it < NIT; it += gridDim.x) {
            const int l = it / (MODW / 64), cb = it % (MODW / 64), j = tid & 63, kg = tid >> 6;
            const float* w = p.w_ada + (size_t)l * DM * MODW + cb * 64 + j;
            float a[9];
#pragma unroll
            for (int r = 0; r < 9; ++r) a[r] = 0.f;
#pragma unroll 16
            for (int k = kg * 128; k < kg * 128 + 128; ++k) { const float wv = w[(size_t)k * MODW];
#pragma unroll
                for (int r = 0; r < 9; ++r) a[r] += sc[r * 1024 + k] * wv; }
#pragma unroll
            for (int r = 0; r < 9; ++r) red[(kg * 9 + r) * 64 + j] = a[r];
            __syncthreads();
            if (tid < 64) { const float bv = p.b_ada[l * MODW + cb * 64 + j];
                for (int r = 0; r < 9; ++r) { float s = 0.f;
#pragma unroll
                    for (int g = 0; g < 8; ++g) s += red[(g * 9 + r) * 64 + j];
                    mod[((size_t)l * 9 + r) * MODW + cb * 64 + j] = s + bv; } }
            __syncthreads();
        }
    }
    if (blockIdx.x == gridDim.x - 1 && tid < 64) {
        float* lam = mod + (size_t)DEPTH * 9 * MODW;
        for (int l = 0; l < DEPTH; ++l) { const float* lv = p.dlam + l * 256;
            const float s01 = wave_sum(lv[tid] * lv[64 + tid]), s23 = wave_sum(lv[128 + tid] * lv[192 + tid]);
            if (tid == 0) { const float li = 0.8f - 0.6f * expf(-0.3f * (float)l); lam[2 * l] = expf(s01) - expf(s23) + li; lam[2 * l + 1] = li; } }
    }
}
__device__ __forceinline__ void init_rows_phase(const Params& p) {
    int tid_ = threadIdx.x; asm volatile("" : "+v"(tid_));
    const int lane = tid_ & 63, gw = blockIdx.x * 8 + (tid_ >> 6), NGW = gridDim.x * 8;
    float* X = (float*)(p.ws + WS_X); bf16_t* U = (bf16_t*)((unsigned char*)p.out + DO_U); const float* mod = (const float*)(p.ws + WS_MOD);
    for (int row0 = gw; row0 < MTOT; row0 += 2 * NGW) {
        f32x4 v[2][4]; int rows[2]; bool ok[2];
#pragma unroll
        for (int r = 0; r < 2; ++r) { const int rr = row0 + r * NGW; ok[r] = rr < MTOT; rows[r] = ok[r] ? rr : row0;
            const float* src = rows[r] < MLAT ? p.x + (size_t)rows[r] * DM : p.ctx + (size_t)(rows[r] - MLAT) * DM;
#pragma unroll
            for (int j = 0; j < 4; ++j) v[r][j] = *(const f32x4*)(src + 4 * lane + 256 * j); }
#pragma unroll
        for (int r = 0; r < 2; ++r) { if (!ok[r]) continue;
            const int row = rows[r]; const int bi = row < MLAT ? row / SEQ : 8;
            const float* sh = mod + (size_t)bi * MODW, *scp = sh + 1024;
#pragma unroll
            for (int j = 0; j < 4; ++j) { const int col = 4 * lane + 256 * j;
                const f32x4 s = *(const f32x4*)(scp + col), h = *(const f32x4*)(sh + col); const f32x4 u = v[r][j] * (s + 1.0f) + h;
                u32x2 w; w.x = pk2(u[0], u[1]); w.y = pk2(u[2], u[3]); *(u32x2*)(U + (size_t)row * DM + col) = w; } }
    }
}
__device__ __forceinline__ void ln_rows(const Params& p, const bf16_t* __restrict__ O, const float* gmod, const float* lng, const float* lnb, const float* nmod  ,
                                        float* outp, int lane, int row_first, int row_step, int row_end, const float* xin_lat = nullptr, const float* xin_ctx = nullptr) {
    float* X = (float*)(p.ws + WS_X); bf16_t* U = (bf16_t*)((unsigned char*)p.out + DO_U);
    for (int row0 = row_first; row0 < row_end; row0 += 2 * row_step) {
        f32x4 xv[2][4]; u32x2 ow[2][4]; int rows[2]; bool ok[2];
#pragma unroll
        for (int r = 0; r < 2; ++r) { const int rr = row0 + r * row_step; ok[r] = rr < row_end; rows[r] = ok[r] ? rr : row0;
#pragma unroll
            for (int j = 0; j < 4; ++j) { const int col = 4 * lane + 256 * j; const float* xs = xin_lat ? (rows[r] < MLAT ? xin_lat + (size_t)rows[r] * DM : xin_ctx + (size_t)(rows[r] - MLAT) * DM) : X + (size_t)rows[r] * DM; xv[r][j] = *(const f32x4*)(xs + col); ow[r][j] = *(const u32x2*)(O + (size_t)rows[r] * DM + col); } }
#pragma unroll
        for (int r = 0; r < 2; ++r) {
            const int row = rows[r]; const int bi = row < MLAT ? row / SEQ : 8;
            const float* g = gmod + (size_t)bi * MODW;
            f32x4 v[4]; float s = 0.f;
#pragma unroll
            for (int j = 0; j < 4; ++j) { const int col = 4 * lane + 256 * j; const f32x4 gv = *(const f32x4*)(g + col); f32x4 ov; ov[0] = bflo(ow[r][j].x); ov[1] = bfhi(ow[r][j].x); ov[2] = bflo(ow[r][j].y); ov[3] = bfhi(ow[r][j].y);
                v[j] = xv[r][j] * ALPHA + gv * ov; s += (v[j][0] + v[j][1]) + (v[j][2] + v[j][3]); }
            const float mean = wave_sum(s) * (1.0f / DM); float s2 = 0.f;
#pragma unroll
            for (int j = 0; j < 4; ++j) { v[j] = v[j] - mean; s2 += (v[j][0] * v[j][0] + v[j][1] * v[j][1]) + (v[j][2] * v[j][2] + v[j][3] * v[j][3]); }
            const float rstd = 1.0f / sqrtf(wave_sum(s2) * (1.0f / DM) + LN_EPS);
            if (ok[r]) {
#pragma unroll
                for (int j = 0; j < 4; ++j) { const int col = 4 * lane + 256 * j; const f32x4 y = v[j] * rstd * *(const f32x4*)(lng + col) + *(const f32x4*)(lnb + col);
                    if (outp) { *(f32x4*)(outp + (size_t)row * DM + col) = y; }
                    else { *(f32x4*)(X + (size_t)row * DM + col) = y;
                        const float* nm = nmod + (size_t)bi * MODW; const f32x4 u = y * (*(const f32x4*)(nm + 1024 + col) + 1.0f) + *(const f32x4*)(nm + col);
                        u32x2 w; w.x = pk2(u[0], u[1]); w.y = pk2(u[2], u[3]); *(u32x2*)(U + (size_t)row * DM + col) = w; } }
            }
        }
    }
}

constexpr int AT_KB = 9216;
#define MFMA32(a, b, c) __builtin_amdgcn_mfma_f32_32x32x16_bf16((a), (b), (c), 0, 0, 0)
__device__ __forceinline__ bf16x8 lds_rd16(const LAS unsigned char* p) { return *(const LAS bf16x8*)p; }
__device__ __forceinline__ bf16x8 lds_rd16v(const LAS unsigned char* p) { return *(const volatile LAS bf16x8*)p; }

__device__ __forceinline__ float max3f(float a, float b, float c) { float r; asm("v_max3_f32 %0, %1, %2, %3" : "=v"(r) : "v"(a), "v"(b), "v"(c)); return r; }
__device__ __forceinline__ float max2f(float a, float b) { float r; asm("v_max_f32_e32 %0, %1, %2" : "=v"(r) : "v"(a), "v"(b)); return r; }
__device__ __forceinline__ float rowmax32(const f32x16& a, const f32x16& b) {
    float m0 = max3f(a[0], a[1], b[0]), m1 = max3f(a[2], a[3], b[1]); m0 = max3f(m0, b[2], b[3]);
#pragma unroll
    for (int r = 4; r < 16; r += 4) { m0 = max3f(m0, a[r], a[r + 1]); m1 = max3f(m1, a[r + 2], a[r + 3]); m0 = max3f(m0, b[r], b[r + 1]); m1 = max3f(m1, b[r + 2], b[r + 3]); }
    const float m = max2f(m0, m1);
    auto rr = __builtin_amdgcn_permlane32_swap(__float_as_uint(m), __float_as_uint(m), false, false);
    return max2f(__uint_as_float(rr[0]), __uint_as_float(rr[1]));
}
constexpr int AT_K0 = 0, AT_V0 = 2 * AT_KB, AT_VB = 128 * 144;
template <int DV> struct AttnState {
    bf16x8 qr[4]; u32x4 kreg, vreg0, vreg1; f32x16 sc0, sc1, sd0, sd1, negm; f32x16 o[DV / 32]; float lsum, mrun;
    const bf16_t* kg; const bf16_t* vg; int kl, vl, koff, voff;
};
template <int DV, bool FULL>
__device__ __forceinline__ void attn_iter(AttnState<DV>& S, int t, int nt, LAS unsigned char* lds) {
    constexpr int NDB = DV / 32;
    const LAS unsigned char* BK = lds + AT_K0 + ((t + 1) & 1) * AT_KB;
    const LAS unsigned char* BV = lds + AT_V0 + (t & 1) * AT_VB;
    if (FULL || t + 2 < nt) *(LAS u32x4*)(lds + AT_K0 + (t & 1) * AT_KB + S.kl) = S.kreg;
    if (FULL || t + 1 < nt) { LAS unsigned char* W = lds + AT_V0 + ((t + 1) & 1) * AT_VB + S.vl; *(LAS u32x4*)W = S.vreg0; if (DV == 128) *(LAS u32x4*)(W + 64 * 144) = S.vreg1; }
    if (FULL || t + 3 < nt) S.kreg = *(const u32x4*)(S.kg + (size_t)(t + 3) * 4096);
    if (FULL || t + 2 < nt) { S.vreg0 = *(const u32x4*)(S.vg + (t + 2) * 64); if (DV == 128) S.vreg1 = *(const u32x4*)(S.vg + (size_t)64 * TK + (t + 2) * 64); }
    f32x16 sn0 = S.negm, sn1 = S.negm;
    if (FULL || t + 1 < nt) {
#pragma unroll
        for (int c = 0; c < 4; ++c) { const bf16x8 kf0 = lds_rd16(BK + S.koff + c * 32), kf1 = lds_rd16(BK + S.koff + 32 * 144 + c * 32);
            sn0 = MFMA32(kf0, S.qr[c], sn0); sn1 = MFMA32(kf1, S.qr[c], sn1); }
    }
    f32x16 p0, p1;
#pragma unroll
    for (int i = 0; i < 16; ++i) { p0[i] = fast_exp2(S.sc0[i]); p1[i] = fast_exp2(S.sc1[i]); }
    { const f32x16 s = p0 + p1; const f32x4 a = (f32x4){s[0], s[1], s[2], s[3]} + (f32x4){s[4], s[5], s[6], s[7]} + (f32x4){s[8], s[9], s[10], s[11]} + (f32x4){s[12], s[13], s[14], s[15]};
      S.lsum += (a[0] + a[1]) + (a[2] + a[3]); }
#pragma unroll
    for (int blk = 0; blk < 2; ++blk)
#pragma unroll
        for (int a = 0; a < 2; ++a) {
            u32x4 pw;
            if (blk == 0) { pw.x = pk2(p0[8 * a], p0[8 * a + 1]); pw.y = pk2(p0[8 * a + 2], p0[8 * a + 3]); pw.z = pk2(p0[8 * a + 4], p0[8 * a + 5]); pw.w = pk2(p0[8 * a + 6], p0[8 * a + 7]); }
            else { pw.x = pk2(p1[8 * a], p1[8 * a + 1]); pw.y = pk2(p1[8 * a + 2], p1[8 * a + 3]); pw.z = pk2(p1[8 * a + 4], p1[8 * a + 5]); pw.w = pk2(p1[8 * a + 6], p1[8 * a + 7]); }
            const bf16x8 pp = __builtin_bit_cast(bf16x8, pw);
#pragma unroll
            for (int d = 0; d < NDB; ++d) { const bf16x8 vf = lds_rd16(BV + S.voff + d * 32 * 144 + (32 * blk + 16 * a) * 2); S.o[d] = MFMA32(vf, pp, S.o[d]); }
        }
    float mx = 0.f;
    if (FULL || t + 1 < nt) mx = rowmax32(sn0, sn1);
    if (FULL || t + 1 < nt) {
        if (__any(mx > 8.0f)) {
            const float dl = fmaxf(mx, 0.f), alpha = fast_exp2(-dl);
            S.mrun += dl; S.lsum *= alpha;
#pragma unroll
            for (int i = 0; i < 16; ++i) { sn0[i] -= dl; sn1[i] -= dl; S.negm[i] = -S.mrun; }
#pragma unroll
            for (int d = 0; d < NDB; ++d)
#pragma unroll
                for (int i = 0; i < 16; ++i) S.o[d][i] *= alpha;
        }
    }
    S.sc0 = sn0; S.sc1 = sn1;
    __syncthreads();
}
template <int DV, int PAR>
__device__ __forceinline__ void attn_iter_full(AttnState<DV>& S, int t, LAS unsigned char* lds) {
    constexpr int NDB = DV / 32, NS = 8 + 4 * NDB, NU = 27;
    const LAS unsigned char* BK = lds + AT_K0 + (PAR ^ 1) * AT_KB + S.koff;
    const LAS unsigned char* BV = lds + AT_V0 + PAR * AT_VB + S.voff;
    f32x16& C0 = PAR ? S.sd0 : S.sc0; f32x16& C1 = PAR ? S.sd1 : S.sc1; f32x16& sn0 = PAR ? S.sc0 : S.sd0; f32x16& sn1 = PAR ? S.sc1 : S.sd1;
    sn0 = S.negm; sn1 = S.negm;
    u32x4 pw[4]; float mxa = 0.f, mxb = 0.f, mx = 0.f; f32x16 ssum;
    constexpr int PD = (DV == 64) ? 3 : 2; bf16x8 fr[PD + 1];
#define AT_FRAG(i) (((i) < 8) ? lds_rd16v(BK + ((i) & 1) * 32 * 144 + ((i) >> 1) * 32) \
                              : lds_rd16v(BV + (((i) - 8) % NDB) * 32 * 144 + (32 * ((((i) - 8) / NDB) >> 1) + 16 * ((((i) - 8) / NDB) & 1)) * 2))
#pragma unroll
    for (int i = 0; i < PD; ++i) fr[i] = AT_FRAG(i);
    __builtin_amdgcn_sched_barrier(0);
#pragma unroll
    for (int i = 0; i < NS; ++i) {
        if (i + PD < NS) fr[(i + PD) % (PD + 1)] = AT_FRAG(i + PD);
        if (i == 3) {
            *(LAS u32x4*)(lds + AT_K0 + PAR * AT_KB + S.kl) = S.kreg;
            LAS unsigned char* W = lds + AT_V0 + (PAR ^ 1) * AT_VB + S.vl; *(LAS u32x4*)W = S.vreg0; if (DV == 128) *(LAS u32x4*)(W + 64 * 144) = S.vreg1; }
        if (i == 5) { S.kreg = *(const u32x4*)(S.kg + (size_t)(t + 3) * 4096);
            S.vreg0 = *(const u32x4*)(S.vg + (t + 2) * 64); if (DV == 128) S.vreg1 = *(const u32x4*)(S.vg + (size_t)64 * TK + (t + 2) * 64); }
        if (i < 8) { if (i & 1) sn1 = MFMA32(fr[i % (PD + 1)], S.qr[i >> 1], sn1); else sn0 = MFMA32(fr[i % (PD + 1)], S.qr[i >> 1], sn0); }
        else { const int j = i - 8; S.o[j % NDB] = MFMA32(fr[i % (PD + 1)], __builtin_bit_cast(bf16x8, pw[j / NDB]), S.o[j % NDB]); }
#pragma unroll
        for (int u = 0; u < NU; ++u) {
            if (u * NS / NU != i) continue;
            if (u < 20) {
                const int q = u / 5, r = u % 5;
                if (r < 4) { const int e = 8 * q + 2 * r;
                    if (e < 16) { C0[e] = fast_exp2(C0[e]); C0[e + 1] = fast_exp2(C0[e + 1]); }
                    else { C1[e - 16] = fast_exp2(C1[e - 16]); C1[e - 15] = fast_exp2(C1[e - 15]); } }
                else { if (q < 2) { const int b0 = 8 * q; pw[q].x = pk2(C0[b0], C0[b0 + 1]); pw[q].y = pk2(C0[b0 + 2], C0[b0 + 3]); pw[q].z = pk2(C0[b0 + 4], C0[b0 + 5]); pw[q].w = pk2(C0[b0 + 6], C0[b0 + 7]); }
                       else { const int b0 = 8 * (q - 2); pw[q].x = pk2(C1[b0], C1[b0 + 1]); pw[q].y = pk2(C1[b0 + 2], C1[b0 + 3]); pw[q].z = pk2(C1[b0 + 4], C1[b0 + 5]); pw[q].w = pk2(C1[b0 + 6], C1[b0 + 7]); } }
            } else if (u == 20) { ssum = C0 + C1; }
            else if (u == 21) { const f32x4 a = (f32x4){ssum[0], ssum[1], ssum[2], ssum[3]} + (f32x4){ssum[4], ssum[5], ssum[6], ssum[7]} + (f32x4){ssum[8], ssum[9], ssum[10], ssum[11]} + (f32x4){ssum[12], ssum[13], ssum[14], ssum[15]};
                S.lsum += (a[0] + a[1]) + (a[2] + a[3]); }
            else if (u == 22) { mxa = max3f(sn0[0], sn0[1], sn1[0]); mxb = max3f(sn0[2], sn0[3], sn1[1]); mxa = max3f(mxa, sn1[2], sn1[3]); }
            else if (u < 26) { const int r = 4 * (u - 22); mxa = max3f(mxa, sn0[r], sn0[r + 1]); mxb = max3f(mxb, sn0[r + 2], sn0[r + 3]); mxa = max3f(mxa, sn1[r], sn1[r + 1]); mxb = max3f(mxb, sn1[r + 2], sn1[r + 3]); }
            else { const float m = max2f(mxa, mxb); auto rr = __builtin_amdgcn_permlane32_swap(__float_as_uint(m), __float_as_uint(m), false, false); mx = max2f(__uint_as_float(rr[0]), __uint_as_float(rr[1])); }
        }
        __builtin_amdgcn_sched_barrier(0);
    }
#undef AT_FRAG
    if (__any(mx > 8.0f)) {
        const float dl = fmaxf(mx, 0.f), alpha = fast_exp2(-dl);
        S.mrun += dl; S.lsum *= alpha;
#pragma unroll
        for (int i = 0; i < 16; ++i) { sn0[i] -= dl; sn1[i] -= dl; S.negm[i] = -S.mrun; }
#pragma unroll
        for (int d = 0; d < NDB; ++d)
#pragma unroll
            for (int i = 0; i < 16; ++i) S.o[d][i] *= alpha;
    }
    __syncthreads();
}
template <int DV>
__device__ __forceinline__ void attn_pass(const bf16_t* __restrict__ Qp, const bf16_t* __restrict__ Kp, const bf16_t* __restrict__ VTp, int nt,
                                          f32x16 (&o)[DV / 32], float& lout, LAS unsigned char* lds) {
    constexpr int NDB = DV / 32;
    int tid_ = threadIdx.x; asm volatile("" : "+v"(tid_));
    const int tid = tid_, lane = tid & 63, wid = tid >> 6, r32 = lane & 31, hi = lane >> 5;
    AttnState<DV> S;
    { const bf16_t* qrow = Qp + (size_t)(wid * 32 + r32) * 64 + hi * 8;
#pragma unroll
      for (int c = 0; c < 4; ++c) S.qr[c] = *(const bf16x8*)(qrow + c * 16); }
    const int lrow = tid >> 3, lseg = tid & 7;
    S.kg = Kp + (size_t)lrow * 64 + lseg * 8;
    S.vg = VTp + (size_t)lrow * TK + lseg * 8;
    S.kl = lrow * 144 + lseg * 16; S.vl = lrow * 144 + lseg * 16;
    const int kvr = (r32 & ~12) | (((r32 >> 2) & 1) << 3) | (((r32 >> 3) & 1) << 2);
    S.koff = kvr * 144 + hi * 16; S.voff = r32 * 144 + hi * 16;
    { const u32x4 k0 = *(const u32x4*)S.kg, k1 = *(const u32x4*)(S.kg + 4096), v0 = *(const u32x4*)S.vg;
      u32x4 v0b; if (DV == 128) v0b = *(const u32x4*)(S.vg + (size_t)64 * TK);
      *(LAS u32x4*)(lds + AT_K0 + S.kl) = k0; *(LAS u32x4*)(lds + AT_K0 + AT_KB + S.kl) = k1; *(LAS u32x4*)(lds + AT_V0 + S.vl) = v0; if (DV == 128) *(LAS u32x4*)(lds + AT_V0 + S.vl + 64 * 144) = v0b; }
    if (nt > 2) S.kreg = *(const u32x4*)(S.kg + (size_t)2 * 4096);
    S.vreg0 = *(const u32x4*)(S.vg + 64); if (DV == 128) S.vreg1 = *(const u32x4*)(S.vg + (size_t)64 * TK + 64);
    __syncthreads();
#pragma unroll
    for (int d = 0; d < NDB; ++d)
#pragma unroll
        for (int i = 0; i < 16; ++i) S.o[d][i] = 0.f;
    S.lsum = 0.f;
    {
        f32x16 s0, s1;
#pragma unroll
        for (int i = 0; i < 16; ++i) { s0[i] = 0.f; s1[i] = 0.f; }
#pragma unroll
        for (int c = 0; c < 4; ++c) { const bf16x8 kf0 = lds_rd16(lds + AT_K0 + S.koff + c * 32), kf1 = lds_rd16(lds + AT_K0 + S.koff + 32 * 144 + c * 32);
            s0 = MFMA32(kf0, S.qr[c], s0); s1 = MFMA32(kf1, S.qr[c], s1); }
        const float mx = rowmax32(s0, s1);
        S.mrun = mx;
#pragma unroll
        for (int i = 0; i < 16; ++i) { S.sc0[i] = s0[i] - mx; S.sc1[i] = s1[i] - mx; S.negm[i] = -mx; }
    }
    __syncthreads();
    int t = 0;
    for (; t + 4 < nt; t += 2) { attn_iter_full<DV, 0>(S, t, lds); attn_iter_full<DV, 1>(S, t + 1, lds); }
    for (; t < nt; ++t) attn_iter<DV, false>(S, t, nt, lds);
#pragma unroll
    for (int d = 0; d < NDB; ++d) o[d] = S.o[d];
    lout = S.lsum + __shfl_xor(S.lsum, 32);
}

__device__ __forceinline__ void diff_unit(const Params& p, int l, int b, int h, int qb, bool ctxq, LAS unsigned char* lds) {
    int tid_ = threadIdx.x; asm volatile("" : "+v"(tid_));
    const int lane = tid_ & 63, wid = tid_ >> 6, r32 = lane & 31, hi = lane >> 5;
    const bf16_t* Q1; const bf16_t* Q2; int nt; size_t yrow;
    if (ctxq) { Q1 = (const bf16_t*)(p.ws + WS_QDC) + (size_t)(b * 8 + 2 * h) * CTX * 64; Q2 = Q1 + (size_t)CTX * 64; nt = CTX / 64; yrow = (size_t)MLAT + b * CTX + wid * 32 + r32; }
    else { Q1 = (const bf16_t*)(p.ws + WS_QD) + ((size_t)(b * 8 + 2 * h) * SEQ + qb * 256) * 64; Q2 = Q1 + (size_t)SEQ * 64; nt = TK / 64; yrow = (size_t)b * SEQ + qb * 256 + wid * 32 + r32; }
    const bf16_t* K1 = (const bf16_t*)(p.ws + WS_KD) + (size_t)(b * 8 + 2 * h) * TK * 64; const bf16_t* K2 = K1 + (size_t)TK * 64;
    const bf16_t* VT = (const bf16_t*)(p.ws + WS_VDT) + (size_t)(b * 4 + h) * 128 * TK;
    const float* lamp = (const float*)(p.ws + WS_MOD) + (size_t)DEPTH * 9 * MODW + 2 * l;
    const float lam = lamp[0], lam_init = lamp[1];
    f32x16 o1[4], o2[4]; float l1, l2;
    LAS unsigned* stash = (LAS unsigned*)(lds + AT_V0 + 2 * AT_VB) + tid_;
    attn_pass<128>(Q1, K1, VT, nt, o1, l1, lds);
    { const float i1 = 1.0f / l1;
#pragma unroll
      for (int d = 0; d < 4; ++d)
#pragma unroll
          for (int i = 0; i < 8; ++i) stash[(d * 8 + i) * 512] = pk2(o1[d][2 * i] * i1, o1[d][2 * i + 1] * i1); }
    attn_pass<128>(Q2, K2, VT, nt, o2, l2, lds);
    const float c2 = lam / l2; float ss = 0.f;
#pragma unroll
    for (int d = 0; d < 4; ++d)
#pragma unroll
        for (int i = 0; i < 8; ++i) { const unsigned w = stash[(d * 8 + i) * 512]; o1[d][2 * i] = bflo(w) - c2 * o2[d][2 * i]; o1[d][2 * i + 1] = bfhi(w) - c2 * o2[d][2 * i + 1]; ss += o1[d][2 * i] * o1[d][2 * i] + o1[d][2 * i + 1] * o1[d][2 * i + 1]; }
    ss += __shfl_xor(ss, 32);
    const float r = __builtin_amdgcn_rsqf(ss * (1.0f / 128.0f) + LN_EPS) * (1.0f - lam_init);
    const float* gn = p.dnorm_g + l * 128;
    bf16_t* yp = (bf16_t*)(p.ws + WS_Y) + yrow * DM + 256 + h * 128;
#pragma unroll
    for (int d = 0; d < 4; ++d)
#pragma unroll
        for (int ig = 0; ig < 4; ++ig) { const int dd = 32 * d + 8 * ig + 4 * hi; const f32x4 g4 = *(const f32x4*)(gn + dd);
            u32x2 w; w.x = pk2(o1[d][4 * ig] * r * g4[0], o1[d][4 * ig + 1] * r * g4[1]); w.y = pk2(o1[d][4 * ig + 2] * r * g4[2], o1[d][4 * ig + 3] * r * g4[3]);
            *(u32x2*)(yp + dd) = w; }
}
__device__ __forceinline__ void gqa_unit(const Params& p, int b, int hq, int qb, bool ctxq, LAS unsigned char* lds) {
    int tid_ = threadIdx.x; asm volatile("" : "+v"(tid_));
    const int lane = tid_ & 63, wid = tid_ >> 6, r32 = lane & 31, hi = lane >> 5;
    const bf16_t* Q; int nt; size_t yrow;
    if (ctxq) { Q = (const bf16_t*)(p.ws + WS_QGC) + (size_t)(b * 4 + hq) * CTX * 64; nt = CTX / 64; yrow = (size_t)MLAT + b * CTX + wid * 32 + r32; }
    else { Q = (const bf16_t*)(p.ws + WS_QG) + ((size_t)(b * 4 + hq) * SEQ + qb * 256) * 64; nt = TK / 64; yrow = (size_t)b * SEQ + qb * 256 + wid * 32 + r32; }
    const int kvh = hq >> 1;
    const bf16_t* K = (const bf16_t*)(p.ws + WS_KG) + (size_t)(b * 2 + kvh) * TK * 64;
    const bf16_t* VT = (const bf16_t*)(p.ws + WS_VGT) + (size_t)(b * 2 + kvh) * 64 * TK;
    f32x16 o[2]; float ls;
    attn_pass<64>(Q, K, VT, nt, o, ls, lds);
    const float il = 1.0f / ls;
    bf16_t* yp = (bf16_t*)(p.ws + WS_Y) + yrow * DM + 768 + hq * 64;
#pragma unroll
    for (int d = 0; d < 2; ++d)
#pragma unroll
        for (int ig = 0; ig < 4; ++ig) { const int dd = 32 * d + 8 * ig + 4 * hi;
            u32x2 w; w.x = pk2(o[d][4 * ig] * il, o[d][4 * ig + 1] * il); w.y = pk2(o[d][4 * ig + 2] * il, o[d][4 * ig + 3] * il);
            *(u32x2*)(yp + dd) = w; }
}

constexpr int ML_QS = 0, ML_KS = 9216, ML_KT = 18432, ML_VT = 27648, ML_SW = 36864, ML_CT0 = 46080, ML_CT1 = 55296, ML_TAB = 64512, ML_GSZ = 67072;
constexpr int T_A = 0, T_BIGA = 256, T_WP = 512, T_U = 768, T_EMT = 1024, T_DP0 = 1280, T_DP1 = 1536, T_DI = 1792, T_NV0 = 2048, T_NV1 = 2304;
constexpr size_t ML_UNIT_BYTES = (size_t)3 * TK * 64 * 2 + (size_t)2 * TK * 16;

__device__ __forceinline__ void mlstm_unit(const Params& p, int l, int b, int h, LAS unsigned char* lds) {
    int tid_ = threadIdx.x; asm volatile("" : "+v"(tid_));
    const int tid = tid_, lane = tid & 63, wave = __builtin_amdgcn_readfirstlane(tid >> 6), g = wave >> 2, w4 = wave & 3, tid4 = tid & 255, r32 = lane & 31, hi = lane >> 5;
    LAS unsigned char* L = lds + g * ML_GSZ;
    const bf16_t* Pm = (const bf16_t*)(p.ws + WS_PM);
    const bf16_t* MVt = (const bf16_t*)(p.ws + WS_MVT) + (size_t)(b * 4 + h) * 64 * TK;
    const float* G = (const float*)(p.ws + WS_GATES);
    unsigned char* ub = p.ws + WS_ML + (size_t)(b * 4 + h) * ML_UNIT_BYTES;
    bf16_t* QA = (bf16_t*)ub; bf16_t* KA = QA + (size_t)TK * 64; bf16_t* KAT = KA + (size_t)TK * 64; f32x4* SC = (f32x4*)(KAT + (size_t)TK * 64);
    bf16_t* HX = (bf16_t*)((unsigned char*)p.out + (g ? DO_HB : DO_HF));
    const int ctxrow0 = MLAT + b * CTX, latrow0 = b * SEQ;
    for (int i = tid4; i < ML_GSZ / 16; i += 256) *(LAS u32x4*)(L + i * 16) = (u32x4){0u, 0u, 0u, 0u};
    {
        float wq[5], wk[5], bq, bk;
        { const float* cw = p.conv_w + (size_t)l * 5 * 512; const float* cb = p.conv_b + l * 512;
#pragma unroll
          for (int j = 0; j < 5; ++j) { wq[j] = cw[j * 512 + h * 64 + lane]; wk[j] = cw[j * 512 + 256 + h * 64 + lane]; }
          bq = cb[h * 64 + lane]; bk = cb[256 + h * 64 + lane]; }
#define PP_LOAD(gi_, QR, KR, MSK) do { const int tau0_ = (gi_) * 8; const bool isc_ = tau0_ < CTX; const int lo_ = isc_ ? 0 : CTX, hi_ = isc_ ? CTX : TK; MSK = 0u; \
            _Pragma("unroll") for (int i_ = 0; i_ < 12; ++i_) { const int tau_ = tau0_ - 2 + i_; const bool ok_ = tau_ >= lo_ && tau_ < hi_; const int tc_ = ok_ ? tau_ : tau0_; \
                const size_t row_ = tc_ < CTX ? (size_t)(ctxrow0 + tc_) : (size_t)(latrow0 + tc_ - CTX); const bf16_t* src_ = Pm + row_ * 768 + h * 64 + lane; QR[i_] = src_[0]; KR[i_] = src_[256]; MSK |= ok_ ? (1u << i_) : 0u; } } while (0)
        unsigned short qa_[12], ka_[12], qb_[12], kb_[12]; unsigned ma_ = 0u, mb_ = 0u;
        PP_LOAD(wave, qa_, ka_, ma_);
        for (int gi = wave; gi < TK / 8; gi += 8) {
            const int tau0 = gi * 8;
            if (gi + 8 < TK / 8) PP_LOAD(gi + 8, qb_, kb_, mb_);
            float qf[12], kf[12];
#pragma unroll
            for (int i = 0; i < 12; ++i) { const bool ok = (ma_ >> i) & 1u; qf[i] = ok ? bf2f(qa_[i]) : 0.f; kf[i] = ok ? bf2f(ka_[i]) : 0.f; }
            float ko[8];
#pragma unroll
            for (int i = 0; i < 8; ++i) { float qv = bq, kv = bk;
#pragma unroll
                for (int jj = 0; jj < 5; ++jj) { qv += wq[jj] * qf[i + jj]; kv += wk[jj] * kf[i + jj]; }
                const float qo = silu_f(qv) * 0.125f; ko[i] = silu_f(kv);
                QA[(size_t)(tau0 + i) * 64 + lane] = f2bf(qo); KA[(size_t)(tau0 + i) * 64 + lane] = f2bf(ko[i]); }
            u32x4 kt; kt.x = pk2(ko[0], ko[1]); kt.y = pk2(ko[2], ko[3]); kt.z = pk2(ko[4], ko[5]); kt.w = pk2(ko[6], ko[7]);
            *(u32x4*)(KAT + (size_t)lane * TK + tau0) = kt;
#pragma unroll
            for (int i = 0; i < 12; ++i) { qa_[i] = qb_[i]; ka_[i] = kb_[i]; }
            ma_ = mb_;
        }
#undef PP_LOAD
    }
    {
        float ipn, fpn;
#define PB_LOAD(it_, IP, FP) do { const int dir_ = (it_) >= 68, c_ = dir_ ? (it_) - 68 : (it_); const int tk_ = dir_ ? 63 - lane : lane; const int tau_ = c_ * 64 + tk_; \
            const size_t row_ = tau_ < CTX ? (size_t)(ctxrow0 + tau_) : (size_t)(latrow0 + tau_ - CTX); const float* gs_ = G + row_ * 16 + (dir_ ? 4 : 0) + h; IP = gs_[0]; FP = gs_[8]; } while (0)
        float ipc, fpc; PB_LOAD(wave, ipc, fpc);
        for (int it = wave; it < 136; it += 8) {
            if (it + 8 < 136) PB_LOAD(it + 8, ipn, fpn);
            const int dir = it >= 68, c = dir ? it - 68 : it; const int tk = dir ? 63 - lane : lane; const int tau = c * 64 + tk;
            const float ipre = ipc, fpre = fpc;
            const float lf = fminf(fpre, 0.f) - log1pf(expf(-fabsf(fpre)));
            float bc = lf;
#pragma unroll
            for (int d = 1; d < 64; d <<= 1) { const float y = __shfl_up(bc, d); if (lane >= d) bc += y; }
            const float av = ipre - bc;
            float cm = av;
#pragma unroll
            for (int d = 1; d < 64; d <<= 1) { const float y = __shfl_up(cm, d); if (lane >= d) cm = fmaxf(cm, y); }
            SC[(size_t)dir * TK + tau] = (f32x4){bc, av, cm, 0.f};
            ipc = ipn; fpc = fpn;
        }
#undef PB_LOAD
    }
    asm volatile("s_waitcnt vmcnt(0)" ::: "memory"); __syncthreads();
    const int tok = g ? 63 - lane : lane;
    f32x16 Cacc;
#pragma unroll
    for (int i = 0; i < 16; ++i) Cacc[i] = 0.f;
    float nreg = 0.f, mstate = 0.f;
    u32x4 rq0, rq1, rk0, rk1, rt0, rt1, rv0, rv1; f32x4 rsc;
#define CHUNK_OF(j) (g ? ((j) < 4 ? 3 - (j) : 71 - (j)) : (j))
#define ML_PREFETCH(j) do { const int c_ = CHUNK_OF(j); const int rr_ = tid4 >> 2, cc_ = (tid4 & 3) * 16; \
        { const bf16_t* s_ = QA + (size_t)(c_ * 64 + rr_) * 64 + cc_; rq0 = *(const u32x4*)s_; rq1 = *(const u32x4*)(s_ + 8); } \
        { const bf16_t* s_ = KA + (size_t)(c_ * 64 + rr_) * 64 + cc_; rk0 = *(const u32x4*)s_; rk1 = *(const u32x4*)(s_ + 8); } \
        { const bf16_t* s_ = KAT + (size_t)rr_ * TK + c_ * 64 + cc_; rt0 = *(const u32x4*)s_; rt1 = *(const u32x4*)(s_ + 8); } \
        { const bf16_t* s_ = MVt + (size_t)rr_ * TK + c_ * 64 + cc_; rv0 = *(const u32x4*)s_; rv1 = *(const u32x4*)(s_ + 8); } \
        rsc = SC[(size_t)g * TK + c_ * 64 + tok]; } while (0)
#define ML_BAR() asm volatile("s_waitcnt lgkmcnt(0)\n\ts_barrier" ::: "memory")
    ML_PREFETCH(0);
    int cur = 0;
    for (int j = 0; j < 68; ++j) {
        const int cidx = CHUNK_OF(j);
        const float bc = rsc[0], av = rsc[1], cm = rsc[2];
        const float Aq = fmaxf(cm, mstate);
        const float wp = fast_exp(mstate - Aq), emt = fast_exp(-(bc + Aq));
        const float A63 = __shfl(Aq, 63), bl = __shfl(bc, 63);
        const float uu = fast_exp(av - A63), decay = fast_exp(mstate - A63), mnext = bl + A63;
        if (w4 == 0) { LAS float* tb = (LAS float*)(L + ML_TAB); tb[T_A / 4 + tok] = av; tb[T_BIGA / 4 + tok] = Aq; tb[T_WP / 4 + tok] = wp; tb[T_U / 4 + tok] = uu; tb[T_EMT / 4 + tok] = emt; }
        { const int o_ = (tid4 >> 2) * 144 + (tid4 & 3) * 32;
          *(LAS u32x4*)(L + ML_QS + o_) = rq0; *(LAS u32x4*)(L + ML_QS + o_ + 16) = rq1; *(LAS u32x4*)(L + ML_KS + o_) = rk0; *(LAS u32x4*)(L + ML_KS + o_ + 16) = rk1;
          *(LAS u32x4*)(L + ML_KT + o_) = rt0; *(LAS u32x4*)(L + ML_KT + o_ + 16) = rt1; *(LAS u32x4*)(L + ML_VT + o_) = rv0; *(LAS u32x4*)(L + ML_VT + o_ + 16) = rv1; }
        if (j + 1 < 68) ML_PREFETCH(j + 1);
        ML_BAR();
        const LAS unsigned char* CTc = L + (cur ? ML_CT1 : ML_CT0); LAS unsigned char* CTn = L + (cur ? ML_CT0 : ML_CT1);
        const LAS float* tb = (const LAS float*)(L + ML_TAB);
        {
            const int sblk = w4 & 1, tblk = w4 >> 1;
            f32x16 st;
#pragma unroll
            for (int i = 0; i < 16; ++i) st[i] = 0.f;
#pragma unroll
            for (int c = 0; c < 4; ++c) { const bf16x8 af = lds_rd16(L + ML_KS + (32 * sblk + r32) * 144 + hi * 16 + c * 32), bfr = lds_rd16(L + ML_QS + (32 * tblk + r32) * 144 + hi * 16 + c * 32); st = MFMA32(af, bfr, st); }
            const int t = 32 * tblk + r32; const float At = tb[T_BIGA / 4 + t];
            float dsum = 0.f;
#pragma unroll
            for (int ig = 0; ig < 4; ++ig) { const int s0 = 32 * sblk + 8 * ig + 4 * hi; const f32x4 a4 = *(const LAS f32x4*)(L + ML_TAB + T_A + s0 * 4);
                float w[4];
#pragma unroll
                for (int e = 0; e < 4; ++e) { const int s = s0 + e; const bool valid = g ? (s >= t) : (s <= t); const float ex = fast_exp(fminf(a4[e] - At, 0.f)); w[e] = valid ? st[4 * ig + e] * ex : 0.f; dsum += w[e]; }
                u32x2 pw; pw.x = pk2(w[0], w[1]); pw.y = pk2(w[2], w[3]); *(LAS u32x2*)(L + ML_SW + t * 144 + s0 * 2) = pw; }
            dsum += __shfl_xor(dsum, 32);
            if (hi == 0) *(LAS float*)(L + ML_TAB + (sblk ? T_DP1 : T_DP0) + t * 4) = dsum;
        }
        {
            const int dblk = w4 & 1, vblk = w4 >> 1;
#pragma unroll
            for (int i = 0; i < 16; ++i) Cacc[i] *= decay;
#pragma unroll
            for (int c = 0; c < 4; ++c) { const bf16x8 af = lds_rd16(L + ML_KT + (32 * dblk + r32) * 144 + hi * 16 + c * 32);
                const u32x4 vv = *(const LAS u32x4*)(L + ML_VT + (32 * vblk + r32) * 144 + hi * 16 + c * 32);
                const f32x4 u0 = *(const LAS f32x4*)(L + ML_TAB + T_U + (16 * c + 8 * hi) * 4), u1 = *(const LAS f32x4*)(L + ML_TAB + T_U + (16 * c + 8 * hi + 4) * 4);
                u32x4 sv; sv.x = pk2(bflo(vv.x) * u0[0], bfhi(vv.x) * u0[1]); sv.y = pk2(bflo(vv.y) * u0[2], bfhi(vv.y) * u0[3]); sv.z = pk2(bflo(vv.z) * u1[0], bfhi(vv.z) * u1[1]); sv.w = pk2(bflo(vv.w) * u1[2], bfhi(vv.w) * u1[3]);
                Cacc = MFMA32(af, __builtin_bit_cast(bf16x8, sv), Cacc); }
#pragma unroll
            for (int ig = 0; ig < 4; ++ig) { const int d0 = 32 * dblk + 8 * ig + 4 * hi; u32x2 pw; pw.x = pk2(Cacc[4 * ig], Cacc[4 * ig + 1]); pw.y = pk2(Cacc[4 * ig + 2], Cacc[4 * ig + 3]);
                *(LAS u32x2*)(CTn + (32 * vblk + r32) * 144 + d0 * 2) = pw; }
        }
        if (w4 == 0) {
            float s = 0.f;
#pragma unroll
            for (int c = 0; c < 8; ++c) { const u32x4 v = *(const LAS u32x4*)(L + ML_KT + lane * 144 + c * 16); const f32x4 u0 = *(const LAS f32x4*)(L + ML_TAB + T_U + c * 32), u1 = *(const LAS f32x4*)(L + ML_TAB + T_U + c * 32 + 16);
                s += bflo(v.x) * u0[0] + bfhi(v.x) * u0[1] + bflo(v.y) * u0[2] + bfhi(v.y) * u0[3] + bflo(v.z) * u1[0] + bfhi(v.z) * u1[1] + bflo(v.w) * u1[2] + bfhi(v.w) * u1[3]; }
            nreg = decay * nreg + s;
            *(LAS float*)(L + ML_TAB + (cur ? T_NV0 : T_NV1) + lane * 4) = nreg;
        } else if (w4 == 1) {
            const LAS unsigned char* nv = L + ML_TAB + (cur ? T_NV1 : T_NV0); float s = 0.f;
#pragma unroll
            for (int c = 0; c < 8; ++c) { const u32x4 v = *(const LAS u32x4*)(L + ML_QS + lane * 144 + c * 16); const f32x4 n0 = *(const LAS f32x4*)(nv + c * 32), n1 = *(const LAS f32x4*)(nv + c * 32 + 16);
                s += bflo(v.x) * n0[0] + bfhi(v.x) * n0[1] + bflo(v.y) * n0[2] + bfhi(v.y) * n0[3] + bflo(v.z) * n1[0] + bfhi(v.z) * n1[1] + bflo(v.w) * n1[2] + bfhi(v.w) * n1[3]; }
            *(LAS float*)(L + ML_TAB + T_DI + lane * 4) = s;
        }
        ML_BAR();
        {
            const int tblk = w4 & 1, vblk = w4 >> 1;
            f32x16 a1, a2;
#pragma unroll
            for (int i = 0; i < 16; ++i) { a1[i] = 0.f; a2[i] = 0.f; }
#pragma unroll
            for (int c = 0; c < 4; ++c) { const bf16x8 bv = lds_rd16(L + ML_VT + (32 * vblk + r32) * 144 + hi * 16 + c * 32), as = lds_rd16(L + ML_SW + (32 * tblk + r32) * 144 + hi * 16 + c * 32);
                const bf16x8 aq = lds_rd16(L + ML_QS + (32 * tblk + r32) * 144 + hi * 16 + c * 32), bc2 = lds_rd16(CTc + (32 * vblk + r32) * 144 + hi * 16 + c * 32);
                a1 = MFMA32(as, bv, a1); a2 = MFMA32(aq, bc2, a2); }
            const int tau0 = cidx * 64; const size_t rowc = tau0 < CTX ? (size_t)(ctxrow0 + tau0) : (size_t)(latrow0 + tau0 - CTX);
            bf16_t* hp = HX + rowc * 256 + h * 64 + 32 * vblk + r32;
#pragma unroll
            for (int ig = 0; ig < 4; ++ig) { const int t0 = 32 * tblk + 8 * ig + 4 * hi;
                const f32x4 d0 = *(const LAS f32x4*)(L + ML_TAB + T_DP0 + t0 * 4), d1 = *(const LAS f32x4*)(L + ML_TAB + T_DP1 + t0 * 4), di = *(const LAS f32x4*)(L + ML_TAB + T_DI + t0 * 4),
                            w4v = *(const LAS f32x4*)(L + ML_TAB + T_WP + t0 * 4), em = *(const LAS f32x4*)(L + ML_TAB + T_EMT + t0 * 4);
#pragma unroll
                for (int e = 0; e < 4; ++e) { const float den = d0[e] + d1[e] + w4v[e] * di[e]; const float dn = fmaxf(fabsf(den), em[e]);
                    const float hv = (a1[4 * ig + e] + w4v[e] * a2[4 * ig + e]) * fast_rcp(dn); hp[(size_t)(t0 + e) * 256] = f2bf(hv); } }
        }
        mstate = mnext; cur ^= 1;
        ML_BAR();
    }
#undef ML_PREFETCH
#undef ML_BAR
#undef CHUNK_OF
    asm volatile("s_waitcnt vmcnt(0)" ::: "memory"); __syncthreads();
    {
        const bf16_t* HF = (const bf16_t*)((unsigned char*)p.out + DO_HF); const bf16_t* HB = (const bf16_t*)((unsigned char*)p.out + DO_HB);
        bf16_t* Y = (bf16_t*)(p.ws + WS_Y);
        const int seg = tid & 3; const float* gp = p.mnorm_g + l * 256 + h * 64 + seg * 16;
        float gg[16];
#pragma unroll
        for (int i = 0; i < 16; ++i) gg[i] = gp[i];
        for (int it = 0; it < TK / 128; ++it) { const int idx = it * 128 + (tid >> 2); const size_t row = idx < SEQ ? (size_t)b * SEQ + idx : (size_t)MLAT + b * CTX + (idx - SEQ);
            const u32x4 fa = *(const u32x4*)(HF + row * 256 + h * 64 + seg * 16), fb = *(const u32x4*)(HF + row * 256 + h * 64 + seg * 16 + 8);
            const u32x4 ba = *(const u32x4*)(HB + row * 256 + h * 64 + seg * 16), bb = *(const u32x4*)(HB + row * 256 + h * 64 + seg * 16 + 8);
            const u32x4 oa = *(const u32x4*)(Pm + row * 768 + 512 + h * 64 + seg * 16), ob = *(const u32x4*)(Pm + row * 768 + 512 + h * 64 + seg * 16 + 8);
            float v[16], og[16];
            const unsigned fw[8] = {fa.x, fa.y, fa.z, fa.w, fb.x, fb.y, fb.z, fb.w}, bw[8] = {ba.x, ba.y, ba.z, ba.w, bb.x, bb.y, bb.z, bb.w}, ow[8] = {oa.x, oa.y, oa.z, oa.w, ob.x, ob.y, ob.z, ob.w};
            float s = 0.f;
#pragma unroll
            for (int i = 0; i < 8; ++i) { v[2 * i] = bflo(fw[i]) + bflo(bw[i]); v[2 * i + 1] = bfhi(fw[i]) + bfhi(bw[i]); og[2 * i] = bflo(ow[i]); og[2 * i + 1] = bfhi(ow[i]); s += v[2 * i] + v[2 * i + 1]; }
            s += __shfl_xor(s, 1); s += __shfl_xor(s, 2);
            const float mu = s * (1.0f / 64.0f); float s2 = 0.f;
#pragma unroll
            for (int i = 0; i < 16; ++i) { v[i] -= mu; s2 += v[i] * v[i]; }
            s2 += __shfl_xor(s2, 1); s2 += __shfl_xor(s2, 2);
            const float rstd = 1.0f / sqrtf(s2 * (1.0f / 64.0f) + LN_EPS);
            unsigned wv[8];
#pragma unroll
            for (int i = 0; i < 8; ++i) wv[i] = pk2(v[2 * i] * rstd * gg[2 * i] * sigmoid_f(og[2 * i]), v[2 * i + 1] * rstd * gg[2 * i + 1] * sigmoid_f(og[2 * i + 1]));
            bf16_t* yp = Y + row * DM + h * 64 + seg * 16;
            *(u32x4*)yp = (u32x4){wv[0], wv[1], wv[2], wv[3]}; *(u32x4*)(yp + 8) = (u32x4){wv[4], wv[5], wv[6], wv[7]}; }
    }
}

#ifndef PHM
#define PHM 63
#endif
__device__ __forceinline__ unsigned xcc_id() { return (unsigned)__builtin_amdgcn_s_getreg((3 << 11) | 20) & 7u; }
__device__ __forceinline__ void mixer_phase(const Params& p, int l, bool last, LAS unsigned char* lds) {
    unsigned* ctr = (unsigned*)(p.ws + WS_CTL) + 64 * (l + 1);
    LAS int* slot = (LAS int*)(lds + LDS_BYTES - 16);
    const int nper = last ? 132 : 140;
    int q = (int)xcc_id(), tried = 0;
    for (;;) {
        if (threadIdx.x == 0) {
            int it = -1;
            while (tried < 8) { const int v = (int)atomicAdd(ctr + q, 1u); if (v < nper) { it = (q << 8) | v; break; } q = (q + 1) & 7; ++tried; }
            *slot = it;
        }
        __syncthreads();
        const int code = *slot;
        __syncthreads();
        if (code < 0) break;
        const int x = code >> 8; int it = code & 255;
        if (it < 4) { const int m = x * 4 + it; if (PHM & 1) mlstm_unit(p, l, m >> 2, m & 3, lds); }
        else if ((it -= 4) < 64) { const int pr = x + 8 * (it >> 4); if (PHM & 2) diff_unit(p, l, pr >> 2, pr & 3, it & 15, false, lds); }
        else if ((it -= 64) < 64) { const int k = x + 8 * (it >> 5); if (PHM & 4) gqa_unit(p, k >> 1, (k & 1) * 2 + ((it >> 4) & 1), it & 15, false, lds); }
        else if ((it -= 64) < 4) { const int pr = x + 8 * it; if (PHM & 2) diff_unit(p, l, pr >> 2, pr & 3, 0, true, lds); }
        else { it -= 4; const int idx = x + 8 * it; if (PHM & 4) gqa_unit(p, idx >> 2, idx & 3, 0, true, lds); }
        __syncthreads();
    }
    if (!last) wconv_dyn(p, l + 1, 15, (unsigned*)(p.ws + WS_CTL) + 620 + l, lds);
}

__device__ __forceinline__ void ln_ctx_phase(const Params& p, int l, bool last, int which, const bf16_t* A, const bf16_t* Bt, int K, bf16_t* O, const float* gmod, const float* lng, const float* lnb,
                                             const float* nmod, float* outp, unsigned* ctl, LAS unsigned char* lds, const float* xin_lat = nullptr, const float* xin_ctx = nullptr) {
    int tid_ = threadIdx.x; asm volatile("" : "+v"(tid_));
    const int lane = tid_ & 63, wave = tid_ >> 6;
    if (last) { ln_rows(p, O, gmod, lng, lnb, nmod, outp, lane, blockIdx.x * 8 + wave, gridDim.x * 8, MLAT, xin_lat, xin_ctx); return; }
    if (blockIdx.x < 32) {
        const int pm = 128 + ((int)blockIdx.x >> 2), pn = (int)blockIdx.x & 3;
        unsigned* cnt = ctl + 8192 + (l * 2 + which) * 8 + (pm - 128);
        { pg8::Gemm g{A, Bt, MTOT, DM, K}; pg8::SingleOrder S{pm, pn, cnt}; pg8::EpiPlain E{O, DM};
          pg8::gemm_phase<pg8::EpiPlain, pg8::SingleOrder, true, true>(lds, g, S, E); }
        if (tid_ == 0) { while (__hip_atomic_load(cnt, __ATOMIC_RELAXED, __HIP_MEMORY_SCOPE_AGENT) < 32u) __builtin_amdgcn_s_sleep(8); }
        __syncthreads();
        __builtin_amdgcn_fence(__ATOMIC_ACQUIRE, "agent");
        const int base = pm * 256 + pn * 64 + wave * 8;
        ln_rows(p, O, gmod, lng, lnb, nmod, outp, lane, base, 1, base + 8, xin_lat, xin_ctx);
    } else {
        ln_rows(p, O, gmod, lng, lnb, nmod, outp, lane, ((int)blockIdx.x - 32) * 8 + wave, ((int)gridDim.x - 32) * 8, MLAT, xin_lat, xin_ctx);
    }
}

__global__ void __launch_bounds__(512, 2) fwd_megakernel(Params p) {
    extern __shared__ __attribute__((aligned(16))) unsigned char lds_raw[];
    LAS unsigned char* lds = (LAS unsigned char*)lds_raw;
    cg::grid_group grid = cg::this_grid();
    if (threadIdx.x < 16) ((LAS unsigned*)(lds + LDS_BYTES - 64))[threadIdx.x] = 0u;
    __syncthreads();
    const XcdBarrier xb = xcd_barrier_post((unsigned*)(p.ws + WS_CTL) + 4096, (volatile LAS unsigned*)(lds + LDS_BYTES - 64));
    const float* mod = (const float*)(p.ws + WS_MOD);
    unsigned* ctl = (unsigned*)(p.ws + WS_CTL);
    bf16_t* U = (bf16_t*)((unsigned char*)p.out + DO_U);
    mod_phase(p, lds);
    __syncthreads();
    wconv_phase(p, 0, 15, lds);
    grid.sync();
    init_rows_phase(p);
    xcd_barrier(xb);
    for (int l = 0; l < DEPTH; ++l) {
        const bool last = (l == DEPTH - 1);
        const int Mrows = last ? MLAT : MTOT;
        const float* modl = mod + (size_t)l * 9 * MODW;
        {
            pg8::Gemm g{U, (const bf16_t*)(p.ws + WS_WIN), MTOT, NIN, DM}; pg8::StaticOrder S; S.init(MTOT, NIN, gridDim.x, (int)blockIdx.x);
            pg8::EpiIn E{(bf16_t*)(p.ws + WS_PM), (bf16_t*)(p.ws + WS_MVT), (bf16_t*)(p.ws + WS_QD), (bf16_t*)(p.ws + WS_QDC), (bf16_t*)(p.ws + WS_KD), (bf16_t*)(p.ws + WS_VDT),
                         (bf16_t*)(p.ws + WS_QG), (bf16_t*)(p.ws + WS_QGC), (bf16_t*)(p.ws + WS_KG), (bf16_t*)(p.ws + WS_VGT), (float*)(p.ws + WS_GATES),
                         p.gate_b + l * 16, p.qn_g + l * 64, p.kn_g + l * 64};
            if (PHM & 8) pg8::gemm_phase<pg8::EpiIn, pg8::StaticOrder, false, true>(lds, g, S, E);
        }
        xcd_barrier(xb);
        mixer_phase(p, l, last, lds);
        xcd_barrier(xb);
        {
            pg8::Gemm g{(const bf16_t*)(p.ws + WS_Y), (const bf16_t*)(p.ws + ((l & 1) ? WS_WOUTB : WS_WOUT)), MLAT, DM, DM}; pg8::StaticOrder S; S.init(MLAT, DM, gridDim.x, (int)blockIdx.x);
            pg8::EpiPlain E{(bf16_t*)(p.ws + WS_O1), DM};
            if (PHM & 32) pg8::gemm_phase<pg8::EpiPlain, pg8::StaticOrder, true, true>(lds, g, S, E);
        }
        xcd_barrier(xb);
        ln_ctx_phase(p, l, last, 0, (const bf16_t*)(p.ws + WS_Y), (const bf16_t*)(p.ws + ((l & 1) ? WS_WOUTB : WS_WOUT)), DM, (bf16_t*)(p.ws + WS_O1), modl + 2048, p.ln1_g + l * DM, p.ln1_b + l * DM, modl + 3072, nullptr, ctl, lds, l == 0 ? p.x : nullptr, l == 0 ? p.ctx : nullptr);
        xcd_barrier(xb);
        {
            pg8::Gemm g{U, (l & 1) ? (const bf16_t*)((unsigned char*)p.out + DO_WF1B) : (const bf16_t*)(p.ws + WS_WF1), Mrows, NF1, DM}; pg8::StaticOrder S; S.init(Mrows, NF1, gridDim.x, (int)blockIdx.x);
            pg8::EpiSwiglu E{(bf16_t*)(p.ws + WS_H)};
            if (PHM & 16) pg8::gemm_phase<pg8::EpiSwiglu, pg8::StaticOrder, true, true>(lds, g, S, E);
        }
        xcd_barrier(xb);
        {
            pg8::Gemm g{(const bf16_t*)(p.ws + WS_H), (const bf16_t*)(p.ws + ((l & 1) ? WS_WF2B : WS_WF2)), MLAT, DM, DFF}; pg8::StaticOrder S; S.init(MLAT, DM, gridDim.x, (int)blockIdx.x);
            pg8::EpiPlain E{(bf16_t*)(p.ws + WS_O2), DM};
            if (PHM & 32) pg8::gemm_phase<pg8::EpiPlain, pg8::StaticOrder, true, true>(lds, g, S, E);
        }
        xcd_barrier(xb);
        ln_ctx_phase(p, l, last, 1, (const bf16_t*)(p.ws + WS_H), (const bf16_t*)(p.ws + ((l & 1) ? WS_WF2B : WS_WF2)), DFF, (bf16_t*)(p.ws + WS_O2), modl + 5120, p.ln2_g + l * DM, p.ln2_b + l * DM, last ? nullptr : (modl + 9 * MODW), last ? p.out : nullptr, ctl, lds);
        if (!last) { xcd_barrier(xb); }
    }
}

extern "C" void kernel_launch(void* const* d_in, const int* in_sizes, int n_in, void* d_out, int out_size, void* d_ws, size_t ws_size, hipStream_t stream) {
    static int grid = 0;
    if (grid == 0) {
        if (n_in != 22 || out_size != MLAT * DM || ws_size < WS_END) { fprintf(stderr, "kernel_launch: unexpected shapes (n_in %d, out %d, ws %zu)\n", n_in, out_size, ws_size); grid = -1; return; }
        int dev = 0, cus = 0, per_cu = 0;
        hipGetDevice(&dev); hipDeviceGetAttribute(&cus, hipDeviceAttributeMultiprocessorCount, dev);
        if (hipFuncSetAttribute((const void*)fwd_megakernel, hipFuncAttributeMaxDynamicSharedMemorySize, LDS_BYTES) != hipSuccess) { fprintf(stderr, "kernel_launch: hipFuncSetAttribute failed\n"); grid = -1; return; }
        if (hipOccupancyMaxActiveBlocksPerMultiprocessor(&per_cu, (const void*)fwd_megakernel, 512, LDS_BYTES) != hipSuccess || per_cu < 1) { fprintf(stderr, "kernel_launch: occupancy query says %d\n", per_cu); per_cu = 1; }
        (void)hipGetLastError();
        grid = cus * 1;
    }
    if (grid < 0) return;
    hipMemsetAsync((char*)d_ws + WS_CTL, 0, 65536, stream);
    Params p{};
    const float** f = (const float**)&p;
    for (int i = 0; i < 22; ++i) f[i] = (const float*)d_in[i];
    p.out = (float*)d_out; p.ws = (unsigned char*)d_ws;
    void* args[] = {&p};
    hipError_t e = hipLaunchCooperativeKernel((const void*)fwd_megakernel, dim3(grid), dim3(512), args, LDS_BYTES, stream);
    if (e != hipSuccess) fprintf(stderr, "cooperative launch failed: %s (grid %d)\n", hipGetErrorString(e), grid);
}
```

```cpp
#include <hip/hip_runtime.h>
#include <hip/hip_cooperative_groups.h>
#include <cstdio>
#include <cstdint>
namespace cg = cooperative_groups;

#define LAS __attribute__((address_space(3)))
typedef unsigned short bf16_t;
typedef short bf16x8 __attribute__((ext_vector_type(8)));
typedef float f32x4 __attribute__((ext_vector_type(4)));
typedef float f32x16 __attribute__((ext_vector_type(16)));
typedef unsigned u32x4 __attribute__((ext_vector_type(4)));
typedef unsigned u32x2 __attribute__((ext_vector_type(2)));
typedef float f32x2_t __attribute__((ext_vector_type(2)));
typedef __bf16 bf16x2_t __attribute__((ext_vector_type(2)));

__device__ __forceinline__ unsigned pk2(float lo, float hi) { f32x2_t v = {lo, hi}; bf16x2_t b = __builtin_convertvector(v, bf16x2_t); return __builtin_bit_cast(unsigned, b); }
__device__ __forceinline__ bf16_t f2bf(float f) { return (bf16_t)(pk2(f, 0.f) & 0xffffu); }
__device__ __forceinline__ float bf2f(unsigned short h) { return __uint_as_float(((unsigned)h) << 16); }
__device__ __forceinline__ float bflo(unsigned w) { return __uint_as_float(w << 16); }
__device__ __forceinline__ float bfhi(unsigned w) { return __uint_as_float(w & 0xffff0000u); }
__device__ __forceinline__ float fast_exp2(float x) { return __builtin_amdgcn_exp2f(x); }
__device__ __forceinline__ float fast_exp(float x) { return __builtin_amdgcn_exp2f(x * 1.4426950408889634f); }
__device__ __forceinline__ float fast_rcp(float x) { return __builtin_amdgcn_rcpf(x); }
__device__ __forceinline__ float silu_f(float x) { return x * fast_rcp(1.0f + fast_exp(-x)); }
__device__ __forceinline__ float sigmoid_f(float x) { return fast_rcp(1.0f + fast_exp(-x)); }

constexpr int DM = 1024, NB = 8, SEQ = 4096, CTX = 256, DEPTH = 4, TK = SEQ + CTX;
constexpr int MLAT = NB * SEQ, MCTX = NB * CTX, MTOT = MLAT + MCTX;
constexpr int NIN = 3328, INCOLS = 3088, DFF = 2816, NF1 = 2 * DFF;
constexpr float LN_EPS = 1e-5f;
constexpr float ALPHA = 1.681792830507429f;
constexpr float QSC = 0.125f * 1.4426950408889634f;

constexpr size_t MiB = 1u << 20;
constexpr size_t WS_CTL = 0, WS_MOD = 1 * MiB, WS_WIN = 2 * MiB, WS_WOUT = 9 * MiB, WS_WF1 = 11 * MiB, WS_WF2 = 22 * MiB, WS_GATES = 28 * MiB, WS_X = 32 * MiB;
constexpr size_t WS_A = 168 * MiB;
constexpr size_t WS_PM = WS_A, WS_MVT = WS_A + 51 * MiB, WS_QD = WS_A + 68 * MiB, WS_QDC = WS_A + 100 * MiB, WS_KD = WS_A + 102 * MiB, WS_VDT = WS_A + 136 * MiB,
                 WS_QG = WS_A + 170 * MiB, WS_QGC = WS_A + 186 * MiB, WS_KG = WS_A + 187 * MiB, WS_VGT = WS_A + 196 * MiB, WS_Y = WS_A + 206 * MiB;
constexpr size_t WS_H = WS_A, WS_O1 = WS_A, WS_O2 = WS_Y, WS_WF2B = WS_Y + 68 * MiB, WS_ML = WS_WF2B + 6 * MiB, WS_WOUTB = WS_ML + 56 * MiB, WS_END = WS_WOUTB + 2 * MiB;
constexpr size_t DO_U = 0, DO_HF = 68 * MiB, DO_HB = 85 * MiB, DO_WF1B = 102 * MiB;
constexpr int MODW = 6 * DM;
constexpr int LDS_BYTES = 147456;

struct Params {
  const float *x, *c, *ctx, *c_ctx, *w_ada, *b_ada, *w_in, *conv_w, *conv_b, *gate_b, *mnorm_g, *dlam, *dnorm_g, *qn_g, *kn_g, *w_out, *ln1_g, *ln1_b, *w_f1, *w_f2, *ln2_g, *ln2_b;
  float* out; unsigned char* ws;
};
namespace pg8 {
#define PG8_LAS __attribute__((address_space(3)))
typedef unsigned short bf16_t;
typedef short bf16x8 __attribute__((ext_vector_type(8)));
typedef float f32x4 __attribute__((ext_vector_type(4)));
typedef unsigned u32x4 __attribute__((ext_vector_type(4)));
constexpr int BM = 256, BK = 64, HALF = 128, HTB = HALF * BK * 2  , STAGE_BYTES = 8 * HTB, NXCD = 8, WGM = 8;

__host__ __device__ __forceinline__ int lds_byte(int r, int c) { const int st = (r >> 4) * 2 + (c >> 5), rr = r & 15, cc = c & 31, ob = rr * 64 + cc * 2; return st * 1024 + (ob ^ (((ob >> 9) & 1) << 5)); }
__host__ __device__ __forceinline__ void stage_rc(int b, int& R, int& C) { const int st = b / 1024, sb = b % 1024, swz = sb ^ (((sb >> 9) & 1) << 5); R = (st >> 1) * 16 + swz / 64; C = (st & 1) * 32 + (swz % 64) / 2; }
__host__ __device__ __forceinline__ int perm32(int rho) { const int n = rho >> 4, i = rho & 15; return 8 * (i >> 2) + 4 * n + (i & 3); }

struct Unit { int pm, pn; };
struct Gemm { const bf16_t* A; const bf16_t* Bt; int M, N, K; };

struct StaticOrder {
    int nM, nN, nwg, G, c;
    __host__ __device__ void init(int M, int N, int G_, int c_) { nM = M / BM; nN = N / BM; nwg = nM * nN; G = G_; c = c_; }
    __host__ __device__ bool next(int i, Unit& u) const {
        const long L = (long)i * G + c; if (L >= nwg) return false;
        int wgid = (int)L; { const int q = nwg / NXCD, r = nwg % NXCD, xcd = wgid % NXCD, off = wgid / NXCD; wgid = (xcd < r ? xcd * (q + 1) : r * (q + 1) + (xcd - r) * q) + off; }
        const int nig = WGM * nN, gid = wgid / nig, fm = gid * WGM, gsz = (nM - fm) < WGM ? (nM - fm) : WGM;
        u.pm = fm + ((wgid % nig) % gsz); u.pn = (wgid % nig) / gsz; return true;
    }
    __device__ __forceinline__ void a_ready(const Unit&) const {}
    __device__ __forceinline__ void done(const Unit&) const {}
};

struct EpiPlain {
    static constexpr bool PERM = true, AFTER_DRAIN = false;
    bf16_t* O; int ldc;
    __device__ __forceinline__ void operator()(const f32x4 (&acc)[2][2][4][2], const Unit& u, int wr, int wc, int fr, int fq) const {
        const int row0 = u.pm * BM + wr * 64 + fr, col0 = u.pn * BM + wc * 32 + 8 * fq;
#pragma unroll
        for (int ai = 0; ai < 2; ++ai)
#pragma unroll
            for (int m = 0; m < 4; ++m) { bf16_t* rowp = O + (size_t)(row0 + ai * HALF + m * 16) * ldc + col0;
#pragma unroll
                for (int bj = 0; bj < 2; ++bj) { const f32x4 v0 = acc[ai][bj][m][0], v1 = acc[ai][bj][m][1];
                    u32x4 w; w.x = ::pk2(v0[0], v0[1]); w.y = ::pk2(v0[2], v0[3]); w.z = ::pk2(v1[0], v1[1]); w.w = ::pk2(v1[2], v1[3]);
                    *(u32x4*)(rowp + bj * HALF) = w; } }
    }
};
struct EpiSwiglu {
    static constexpr bool PERM = true, AFTER_DRAIN = false;
    bf16_t* H;
    __device__ __forceinline__ void operator()(const f32x4 (&acc)[2][2][4][2], const Unit& u, int wr, int wc, int fr, int fq) const {
        const int row0 = u.pm * BM + wr * 64 + fr, col0 = u.pn * 128 + wc * 32 + 8 * fq;
#pragma unroll
        for (int ai = 0; ai < 2; ++ai)
#pragma unroll
            for (int m = 0; m < 4; ++m) { bf16_t* rowp = H + (size_t)(row0 + ai * HALF + m * 16) * ::DFF + col0;
                const f32x4 g0 = acc[ai][0][m][0], g1 = acc[ai][0][m][1], u0 = acc[ai][1][m][0], u1 = acc[ai][1][m][1];
                float h[8];
#pragma unroll
                for (int e = 0; e < 4; ++e) { h[e] = ::silu_f(g0[e]) * u0[e]; h[4 + e] = ::silu_f(g1[e]) * u1[e]; }
                u32x4 w; w.x = ::pk2(h[0], h[1]); w.y = ::pk2(h[2], h[3]); w.z = ::pk2(h[4], h[5]); w.w = ::pk2(h[6], h[7]);
                *(u32x4*)rowp = w; }
    }
};
struct EpiIn {
    static constexpr bool PERM = true, AFTER_DRAIN = false;
    bf16_t *Pm, *MVt, *Qd, *Qdc, *Kd, *VdT, *Qg, *Qgc, *Kg, *VgT; float* G; const float *gate_b, *qn_g, *kn_g;
    __device__ __forceinline__ void operator()(const f32x4 (&acc)[2][2][4][2], const Unit& u, int wr, int wc, int fr, int fq) const {
        const int ch = u.pn * 4 + wc;
        if (ch > 48) return;
        const bool is_ctx = u.pm >= 128;
        const int b = is_ctx ? (u.pm - 128) : (u.pm >> 4);
        int tbase = (is_ctx ? 0 : (u.pm & 15) * 256) + wr * 64 + fr;
        asm volatile("" : "+v"(tbase));
        const int rowbase = u.pm * BM + wr * 64 + fr;
        if (ch == 48) {
            const f32x4 gb = *(const f32x4*)(gate_b + 4 * fq);
#pragma unroll
            for (int ai = 0; ai < 2; ++ai)
#pragma unroll
                for (int m = 0; m < 4; ++m) *(f32x4*)(G + (size_t)(rowbase + ai * HALF + m * 16) * 16 + 4 * fq) = acc[ai][0][m][0] + gb;
            return;
        }
        if (ch < 8 || (ch >= 12 && ch < 16)) {
            const int cb = (ch < 8 ? ch * 64 : 512 + (ch - 12) * 64) + 4 * fq;
#pragma unroll
            for (int ai = 0; ai < 2; ++ai)
#pragma unroll
                for (int m = 0; m < 4; ++m) { bf16_t* rp = Pm + (size_t)(rowbase + ai * HALF + m * 16) * 768 + cb;
#pragma unroll
                    for (int bj = 0; bj < 2; ++bj)
#pragma unroll
                        for (int n = 0; n < 2; ++n) { const f32x4 v = acc[ai][bj][m][n]; u32x2 w; w.x = ::pk2(v[0], v[1]); w.y = ::pk2(v[2], v[3]); *(u32x2*)(rp + 32 * bj + 16 * n) = w; } }
            return;
        }
        if ((ch >= 8 && ch < 12) || (ch >= 32 && ch < 40) || ch >= 46) {
            bf16_t* base; int doff = 0;
            if (ch < 12) base = MVt + (size_t)(b * 4 + (ch - 8)) * 64 * ::TK;
            else if (ch < 40) { const int c8 = ch - 32; base = VdT + (size_t)(b * 4 + (c8 >> 1)) * 128 * ::TK; doff = 64 * (c8 & 1); }
            else base = VgT + (size_t)(b * 2 + (ch - 46)) * 64 * ::TK;
            const int tc0 = (is_ctx ? 0 : ::CTX) + tbase;
#pragma unroll
            for (int ai = 0; ai < 2; ++ai)
#pragma unroll
                for (int m = 0; m < 4; ++m) { const int tc = tc0 + ai * HALF + m * 16;
#pragma unroll
                    for (int bj = 0; bj < 2; ++bj)
#pragma unroll
                        for (int n = 0; n < 2; ++n) { const f32x4 v = acc[ai][bj][m][n];
#pragma unroll
                            for (int e = 0; e < 4; ++e) base[(size_t)(doff + 32 * bj + 16 * n + 4 * fq + e) * ::TK + tc] = ::f2bf(v[e]); }
                    __builtin_amdgcn_sched_barrier(0); }
            return;
        }
        const bool is_q = (ch < 24) || (ch >= 40 && ch < 44);
        const bool do_norm = ch >= 40;
        bf16_t* base; int toff = 0;
        if (ch < 24) { const int c8 = ch - 16; if (is_ctx) { base = Qdc + (size_t)(b * 8 + c8) * ::CTX * 64; } else { base = Qd + (size_t)(b * 8 + c8) * ::SEQ * 64; } }
        else if (ch < 32) { const int c8 = ch - 24; base = Kd + (size_t)(b * 8 + c8) * ::TK * 64; toff = is_ctx ? 0 : ::CTX; }
        else if (ch < 44) { const int hq = ch - 40; if (is_ctx) { base = Qgc + (size_t)(b * 4 + hq) * ::CTX * 64; } else { base = Qg + (size_t)(b * 4 + hq) * ::SEQ * 64; } }
        else { const int kvh = ch - 44; base = Kg + (size_t)(b * 2 + kvh) * ::TK * 64; toff = is_ctx ? 0 : ::CTX; }
        float invf[4];
#pragma unroll
        for (int e = 0; e < 4; ++e) invf[e] = ::fast_exp2(-(float)(4 * fq + e) * (13.287712379549449f / 16.0f));
        const float* gn = ((ch < 44) ? qn_g : kn_g) + 4 * fq;
        const float osc = is_q ? ::QSC : 1.0f;
#pragma unroll
        for (int ai = 0; ai < 2; ++ai)
#pragma unroll
            for (int m = 0; m < 4; ++m) {
                const int t = tbase + ai * HALF + m * 16;
                float r = osc;
                if (do_norm) {
                    float ss = 0.f;
#pragma unroll
                    for (int bj = 0; bj < 2; ++bj)
#pragma unroll
                        for (int n = 0; n < 2; ++n)
#pragma unroll
                            for (int e = 0; e < 4; ++e) ss += acc[ai][bj][m][n][e] * acc[ai][bj][m][n][e];
                    ss += __shfl_xor(ss, 16); ss += __shfl_xor(ss, 32);
                    r *= __builtin_amdgcn_rsqf(ss * (1.0f / 64.0f) + ::LN_EPS);
                }
                bf16_t* rp = base + (size_t)(toff + t) * 64 + 4 * fq;
#pragma unroll
                for (int bj = 0; bj < 2; ++bj) {
                    f32x4 lo = acc[ai][bj][m][0] * r, hi2 = acc[ai][bj][m][1] * r;
                    if (do_norm) { lo = lo * *(const f32x4*)(gn + 32 * bj); hi2 = hi2 * *(const f32x4*)(gn + 32 * bj + 16); }
                    if (!is_ctx) {
                        const float pos = bj == 0 ? (float)(t >> 6) : (float)(t & 63);
#pragma unroll
                        for (int e = 0; e < 4; ++e) { const float th = pos * invf[e]; const float cs = __cosf(th), sn = __sinf(th);
                            const float a = lo[e], bq = hi2[e]; lo[e] = a * cs - bq * sn; hi2[e] = bq * cs + a * sn; }
                    }
                    u32x2 w; w.x = ::pk2(lo[0], lo[1]); w.y = ::pk2(lo[2], lo[3]); *(u32x2*)(rp + 32 * bj) = w;
                    w.x = ::pk2(hi2[0], hi2[1]); w.y = ::pk2(hi2[2], hi2[3]); *(u32x2*)(rp + 32 * bj + 16) = w;
                    __builtin_amdgcn_sched_barrier(0);
                }
            }
    }
};

struct SingleOrder {
    int pm, pn; unsigned* cnt;
    __device__ bool next(int i, Unit& u) const { if (i > 0) return false; u.pm = pm; u.pn = pn; return true; }
    __device__ __forceinline__ void a_ready(const Unit&) const {}
    __device__ __forceinline__ void done(const Unit&) const { __builtin_amdgcn_fence(__ATOMIC_RELEASE, "agent"); if ((threadIdx.x & 63) == 0) __hip_atomic_fetch_add(cnt, 1u, __ATOMIC_RELAXED, __HIP_MEMORY_SCOPE_AGENT); }
};
template <class Epi, class Sched, bool ALIGN_EPI = false, bool SP2 = false>
__device__ __forceinline__ void gemm_phase(PG8_LAS unsigned char* lds, const Gemm g, const Sched& S, const Epi& E) {
    int tid_ = threadIdx.x; asm volatile("" : "+v"(tid_));
    const int tid = tid_, wid = __builtin_amdgcn_readfirstlane(tid >> 6), lane = tid & 63, wr = wid >> 2, wc = wid & 3, fr = lane & 15, fq = lane >> 4;
    const int K = g.K, nt = K / BK;
    unsigned voffA[2], voffB[2];
#pragma unroll
    for (int i = 0; i < 2; ++i) { int R, C; stage_rc(tid * 16 + i * 8192, R, C); const int Rb = Epi::PERM ? ((R & ~31) + perm32(R & 31)) : R;
        voffA[i] = (unsigned)(R * K + C) * 2u; voffB[i] = (unsigned)(Rb * K + C) * 2u; }
    const size_t kstep = (size_t)(BK * 2);
    const size_t hstep = (size_t)HALF * K * 2;
    const size_t tstep = 2 * hstep;
    const unsigned ldsw = (unsigned)wid * 1024u;
    const int aoff = lds_byte(wr * 64 + fr, fq * 8), boff = lds_byte(wc * 32 + fr, fq * 8);
#define PG8_SA(b, h) (((b) * 2 + (h)) * HTB)
#define PG8_SB(b, h) ((4 + (b) * 2 + (h)) * HTB)
#define PG8_STAGE(bufoff, gbase, voff) do { _Pragma("unroll") for (int _i = 0; _i < 2; ++_i) \
        __builtin_amdgcn_global_load_lds((const unsigned*)((const char*)(gbase) + (voff)[_i]), (PG8_LAS unsigned*)(lds + (bufoff) + ldsw + _i * 8192), 16, 0, 0); } while (0)
#define PG8_LDA(dst, b, h) do { _Pragma("unroll") for (int m = 0; m < 4; ++m) _Pragma("unroll") for (int k = 0; k < 2; ++k) dst[m][k] = *(const PG8_LAS bf16x8*)(lds + PG8_SA(b, h) + aoff + m * 2048 + k * 1024); } while (0)
#define PG8_LDB(dst, b, h) do { _Pragma("unroll") for (int n = 0; n < 2; ++n) _Pragma("unroll") for (int k = 0; k < 2; ++k) dst[n][k] = *(const PG8_LAS bf16x8*)(lds + PG8_SB(b, h) + boff + n * 2048 + k * 1024); } while (0)
#define PG8_MMA(ai, bj, At, Bt) do { __builtin_amdgcn_s_setprio(1); _Pragma("unroll") for (int m = 0; m < 4; ++m) _Pragma("unroll") for (int n = 0; n < 2; ++n) _Pragma("unroll") for (int k = 0; k < 2; ++k) \
        acc[ai][bj][m][n] = __builtin_amdgcn_mfma_f32_16x16x32_bf16(Bt[n][k], At[m][k], acc[ai][bj][m][n], 0, 0, 0); __builtin_amdgcn_s_setprio(0); } while (0)
#define PG8_WAIT_V(n) asm volatile("s_waitcnt vmcnt(" #n ")" ::: "memory")
#define PG8_WAIT_L(n) asm volatile("s_waitcnt lgkmcnt(" #n ")" ::: "memory")
#define PG8_BAR __builtin_amdgcn_s_barrier()
#define PG8_SCHED __builtin_amdgcn_sched_barrier(0)
    Unit cur, nxt; int ui = 0;
    if (!S.next(0, cur)) return;
    f32x4 acc[2][2][4][2];
#pragma unroll
    for (int a = 0; a < 2; ++a)
#pragma unroll
        for (int b = 0; b < 2; ++b)
#pragma unroll
            for (int m = 0; m < 4; ++m)
#pragma unroll
                for (int n = 0; n < 2; ++n) acc[a][b][m][n] = (f32x4){0.f, 0.f, 0.f, 0.f};
    bf16x8 At[4][2], B0[2][2], B1[2][2];
    const char* cA = (const char*)g.A + (size_t)cur.pm * tstep; const char* cB = (const char*)g.Bt + (size_t)cur.pn * tstep;
    S.a_ready(cur);
    if constexpr (SP2) {
        PG8_STAGE(PG8_SB(0, 0), cB, voffB); PG8_STAGE(PG8_SB(0, 1), cB + hstep, voffB); PG8_STAGE(PG8_SA(0, 0), cA, voffA); PG8_STAGE(PG8_SA(0, 1), cA + hstep, voffA);
        if (wr == 1) PG8_BAR;
        PG8_WAIT_V(2); PG8_BAR;
        PG8_STAGE(PG8_SB(1, 0), cB + kstep, voffB); PG8_STAGE(PG8_SA(1, 0), cA + kstep, voffA); PG8_STAGE(PG8_SB(1, 1), cB + hstep + kstep, voffB);
        PG8_WAIT_V(6); PG8_BAR;
    } else {
        PG8_STAGE(PG8_SB(0, 0), cB, voffB); PG8_STAGE(PG8_SA(0, 0), cA, voffA); PG8_STAGE(PG8_SB(0, 1), cB + hstep, voffB); PG8_STAGE(PG8_SA(0, 1), cA + hstep, voffA);
        if (wr == 1) PG8_BAR;
        PG8_WAIT_V(4); PG8_BAR;
        PG8_STAGE(PG8_SB(1, 0), cB + kstep, voffB); PG8_STAGE(PG8_SA(1, 0), cA + kstep, voffA); PG8_STAGE(PG8_SB(1, 1), cB + hstep + kstep, voffB);
        PG8_WAIT_V(6); PG8_BAR;
    }
    for (;;) {
        const bool has_next = S.next(ui + 1, nxt);
        const char* nA = has_next ? (const char*)g.A + (size_t)nxt.pm * tstep : cA; const char* nB = has_next ? (const char*)g.Bt + (size_t)nxt.pn * tstep : cB;
        for (int t = 0; t < nt; t += 2) {
            const bool last = (t == nt - 2);
            const char* a1 = cA + (size_t)(t + 1) * kstep;
            const char* a2 = last ? nA : cA + (size_t)(t + 2) * kstep; const char* b2 = last ? nB : cB + (size_t)(t + 2) * kstep;
            const char* a3 = a2 + kstep; const char* b3 = b2 + kstep;
            if (last && has_next) S.a_ready(nxt);
            if constexpr (SP2) {
            PG8_LDB(B0, 0, 0); PG8_LDB(B1, 0, 1); PG8_SCHED; PG8_LDA(At, 0, 0); PG8_STAGE(PG8_SA(1, 1), a1 + hstep, voffA);
            PG8_WAIT_V(8); PG8_WAIT_L(0); PG8_BAR; PG8_MMA(0, 0, At, B0); PG8_MMA(0, 1, At, B1); PG8_BAR; PG8_SCHED;
            PG8_LDA(At, 0, 1); PG8_STAGE(PG8_SB(0, 0), b2, voffB); PG8_STAGE(PG8_SB(0, 1), b2 + hstep, voffB); PG8_STAGE(PG8_SA(0, 0), a2, voffA);
            PG8_WAIT_V(8); PG8_WAIT_L(0); PG8_BAR; PG8_MMA(1, 0, At, B0); PG8_MMA(1, 1, At, B1); PG8_BAR; PG8_SCHED;
            PG8_LDB(B0, 1, 0); PG8_LDB(B1, 1, 1); PG8_SCHED; PG8_LDA(At, 1, 0); PG8_STAGE(PG8_SA(0, 1), a2 + hstep, voffA);
            PG8_WAIT_V(8); PG8_WAIT_L(0); PG8_BAR; PG8_MMA(0, 0, At, B0); PG8_MMA(0, 1, At, B1); PG8_BAR; PG8_SCHED;
            PG8_LDA(At, 1, 1); PG8_STAGE(PG8_SB(1, 0), b3, voffB); PG8_STAGE(PG8_SB(1, 1), b3 + hstep, voffB); PG8_STAGE(PG8_SA(1, 0), a3, voffA);
            PG8_WAIT_V(8); PG8_WAIT_L(0); PG8_BAR; PG8_MMA(1, 0, At, B0); PG8_MMA(1, 1, At, B1); PG8_BAR; PG8_SCHED;
            } else {
            PG8_LDB(B0, 0, 0); PG8_SCHED; PG8_LDA(At, 0, 0); PG8_STAGE(PG8_SA(1, 1), a1 + hstep, voffA);
            PG8_WAIT_L(8); PG8_BAR; PG8_WAIT_L(0); PG8_MMA(0, 0, At, B0); PG8_BAR; PG8_SCHED;
            PG8_LDB(B1, 0, 1); PG8_STAGE(PG8_SB(0, 0), b2, voffB);
            PG8_BAR; PG8_WAIT_L(0); PG8_MMA(0, 1, At, B1); PG8_BAR;
            PG8_LDA(At, 0, 1); PG8_STAGE(PG8_SA(0, 0), a2, voffA);
            PG8_BAR; PG8_WAIT_L(0); PG8_MMA(1, 0, At, B0); PG8_BAR; PG8_SCHED;
            PG8_STAGE(PG8_SB(0, 1), b2 + hstep, voffB);
            PG8_WAIT_V(6); PG8_BAR; PG8_MMA(1, 1, At, B1); PG8_BAR;
            PG8_LDB(B0, 1, 0); PG8_SCHED; PG8_LDA(At, 1, 0); PG8_STAGE(PG8_SA(0, 1), a2 + hstep, voffA);
            PG8_WAIT_L(8); PG8_BAR; PG8_WAIT_L(0); PG8_MMA(0, 0, At, B0); PG8_BAR; PG8_SCHED;
            PG8_LDB(B1, 1, 1); PG8_STAGE(PG8_SB(1, 0), b3, voffB);
            PG8_BAR; PG8_WAIT_L(0); PG8_MMA(0, 1, At, B1); PG8_BAR;
            PG8_LDA(At, 1, 1); PG8_STAGE(PG8_SA(1, 0), a3, voffA);
            PG8_BAR; PG8_WAIT_L(0); PG8_MMA(1, 0, At, B0); PG8_BAR; PG8_SCHED;
            PG8_STAGE(PG8_SB(1, 1), b3 + hstep, voffB);
            PG8_WAIT_V(6); PG8_BAR; PG8_MMA(1, 1, At, B1); PG8_BAR;
            }
        }
        if constexpr (ALIGN_EPI) { if (wr == 0) PG8_BAR; }
        if constexpr (!Epi::AFTER_DRAIN) { E(acc, cur, wr, wc, fr, fq); S.done(cur); }
        if (!has_next) break;
#pragma unroll
        for (int a = 0; a < 2; ++a)
#pragma unroll
            for (int b = 0; b < 2; ++b)
#pragma unroll
                for (int m = 0; m < 4; ++m)
#pragma unroll
                    for (int n = 0; n < 2; ++n) acc[a][b][m][n] = (f32x4){0.f, 0.f, 0.f, 0.f};
        cur = nxt; cA = nA; cB = nB; ++ui;
        if constexpr (ALIGN_EPI) { if (wr == 1) PG8_BAR; }
    }
    PG8_WAIT_V(0);
    if constexpr (!ALIGN_EPI) { if (wr == 0) PG8_BAR; }
    PG8_BAR;
    if constexpr (Epi::AFTER_DRAIN) { E.fused(acc, cur, wr, wc, fr, fq, lds, wid, lane); S.done(cur); }
#undef PG8_SA
#undef PG8_SB
#undef PG8_STAGE
#undef PG8_LDA
#undef PG8_LDB
#undef PG8_MMA
#undef PG8_WAIT_V
#undef PG8_WAIT_L
#undef PG8_BAR
#undef PG8_SCHED
}
}
#define XB_TMO      128
#define XB_XCNT(j)  (256  + 64 * (j))
#define XB_XSUB(j)  (1280 + 64 * (j))
#define XB_XGEN(j)  (2304 + 64 * (j))
#define XB_TOP      3328
#define XB_TOPGEN   3392
#define XCD_BAR_WORDS 3456
#define XB_SPIN_CAP (1u << 18)

__device__ __forceinline__ unsigned xb_ld(unsigned* p)              { return __hip_atomic_load(p, __ATOMIC_RELAXED, __HIP_MEMORY_SCOPE_AGENT); }
__device__ __forceinline__ unsigned xb_add(unsigned* p, unsigned v) { return __hip_atomic_fetch_add(p, v, __ATOMIC_RELAXED, __HIP_MEMORY_SCOPE_AGENT); }
__device__ __forceinline__ unsigned xb_xcc_id() { return (unsigned)__builtin_amdgcn_s_getreg((3 << 11) | 20) & 0xFu; }
#define XB_SPIN(cond, bar) do { unsigned _sp = 0; while (cond) { __builtin_amdgcn_s_sleep(1); \
    if ((++_sp & 255u) == 0u) { if (xb_ld(&(bar)[XB_TMO])) break; if (_sp > XB_SPIN_CAP) { atomicAdd(&(bar)[XB_TMO], 1u); break; } } } } while (0)

struct XcdBarrier {
    unsigned* bar; unsigned x;
    volatile LAS unsigned* st;
};

__device__ __forceinline__ XcdBarrier xcd_barrier_post(unsigned* bar, volatile LAS unsigned* st) {
    XcdBarrier b; b.bar = bar; b.x = xb_xcc_id(); b.st = st;
    if (threadIdx.x == 0) (void)xb_add(&bar[XB_XCNT(b.x)], 1u);
    return b;
}
__device__ __forceinline__ void xcd_barrier_complete(unsigned* bar, unsigned x, unsigned& nloc, unsigned& nx) {
    const unsigned G = gridDim.x * gridDim.y * gridDim.z;
    unsigned sum, cnt, mine, sp = 0u;
    for (;;) {
        sum = 0u; cnt = 0u; mine = 0u;
#pragma unroll
        for (unsigned j = 0; j < 16; ++j) { const unsigned c = xb_ld(&bar[XB_XCNT(j)]); sum += c; cnt += (c > 0u) ? 1u : 0u; mine = (j == x) ? c : mine; }
        if (sum == G) break;
        __builtin_amdgcn_s_sleep(1);
        if ((++sp & 255u) == 0u) { if (xb_ld(&bar[XB_TMO])) break; if (sp > XB_SPIN_CAP) { atomicAdd(&bar[XB_TMO], 1u); break; } }
    }
    nloc = mine > 0u ? mine : 1u; nx = cnt > 0u ? cnt : 1u;
}

__device__ __forceinline__ void xcd_barrier(const XcdBarrier& b_in) {
    XcdBarrier b = b_in; { unsigned xx_ = (unsigned)__builtin_amdgcn_readfirstlane((int)b.x); asm volatile("" : "+s"(xx_)); b.x = xx_; }
    asm volatile("s_waitcnt vmcnt(0)" ::: "memory");
    __syncthreads();
    if (threadIdx.x == 0) {
        unsigned* bar = b.bar;
        __builtin_amdgcn_s_waitcnt(0);
        unsigned nloc = b.st[0], nx = b.st[1];
        if (nloc == 0u) { xcd_barrier_complete(bar, b.x, nloc, nx); b.st[0] = nloc; b.st[1] = nx; }
        const unsigned old = xb_add(&bar[XB_XSUB(b.x)], 1u);
        const unsigned gen = old / nloc;
        if (old + 1u == (gen + 1u) * nloc) {
            __builtin_amdgcn_fence(__ATOMIC_RELEASE, "agent");
            asm volatile("s_waitcnt vmcnt(0)" ::: "memory");
            const unsigned og = xb_add(&bar[XB_TOP], 1u);
            const unsigned tg = og / nx;
            if (og + 1u == (tg + 1u) * nx) xb_add(&bar[XB_TOPGEN], 1u);
            else XB_SPIN(xb_ld(&bar[XB_TOPGEN]) == tg, bar);
            __builtin_amdgcn_fence(__ATOMIC_ACQUIRE, "agent");
            xb_add(&bar[XB_XGEN(b.x)], 1u);
            asm volatile("s_waitcnt vmcnt(0)" ::: "memory");
        } else {
            XB_SPIN(xb_ld(&bar[XB_XGEN(b.x)]) == gen, bar);
            __builtin_amdgcn_fence(__ATOMIC_ACQUIRE, "agent");
            asm volatile("s_waitcnt vmcnt(0)" ::: "memory");
        }
    }
    __syncthreads();
}

__device__ __forceinline__ float wave_sum(float v) {
#pragma unroll
    for (int o = 1; o < 64; o <<= 1) v += __shfl_xor(v, o);
    return v;
}
__device__ __forceinline__ int win_col(int p) {
    const int pn = p >> 8, q = p & 255, bj = q >> 7, wc = (q >> 5) & 3, x = q & 31, n = (x >> 2) & 1, fq = x >> 3, e = x & 3;
    const int delta = 32 * bj + 16 * n + 4 * fq + e, ch = 4 * pn + wc;
    if (ch < 16) return ch * 64 + delta;
    if (ch < 48) return 1040 + (ch - 16) * 64 + delta;
    if (ch == 48 && delta < 16) return 1024 + delta;
    return -1;
}
__device__ __forceinline__ int wf1_col(int p) {
    const int pn = p >> 8, q = p & 255, bj = q >> 7, r = q & 127;
    return bj * DFF + 128 * pn + r;
}
struct WcItem { const float* W; bf16_t* Wt; int K, Nlog, k0, n0, mode; };
__device__ __forceinline__ WcItem wc_decode(const Params& p, int l, int which, int it) {
    constexpr int I0 = 16 * (NIN / 64), I1 = 16 * 16, I2 = 16 * (NF1 / 64);
    const int n0 = (which & 1) ? I0 : 0, n1 = (which & 2) ? I1 : 0, n2 = (which & 4) ? I2 : 0;
    WcItem w; int r = it, ntn;
    if (r < n0) { w.W = p.w_in + (size_t)l * DM * INCOLS; w.Wt = (bf16_t*)(p.ws + WS_WIN); w.K = DM; w.Nlog = INCOLS; ntn = NIN / 64; w.mode = 0; }
    else if ((r -= n0) < n1) { w.W = p.w_out + (size_t)l * DM * DM; w.Wt = (bf16_t*)(p.ws + ((l & 1) ? WS_WOUTB : WS_WOUT)); w.K = DM; w.Nlog = DM; ntn = 16; w.mode = 1; }
    else if ((r -= n1) < n2) { w.W = p.w_f1 + (size_t)l * DM * NF1; w.Wt = (l & 1) ? (bf16_t*)((unsigned char*)p.out + DO_WF1B) : (bf16_t*)(p.ws + WS_WF1); w.K = DM; w.Nlog = NF1; ntn = NF1 / 64; w.mode = 2; }
    else { r -= n2; w.W = p.w_f2 + (size_t)l * DFF * DM; w.Wt = (bf16_t*)(p.ws + ((l & 1) ? WS_WF2B : WS_WF2)); w.K = DFF; w.Nlog = DM; ntn = 16; w.mode = 1; }
    w.k0 = (r / ntn) * 64; w.n0 = (r % ntn) * 64;
    return w;
}
__device__ __forceinline__ void wc_load(const WcItem& w, int tid, float (&v)[8]) {
    const int nn = tid & 63, kk = tid >> 6, pcol = w.n0 + nn;
    const int col = w.mode == 0 ? win_col(pcol) : (w.mode == 2 ? wf1_col(pcol) : pcol);
    const float* src = w.W + (size_t)(w.k0 + kk) * w.Nlog + (col >= 0 ? col : 0);
#pragma unroll
    for (int i = 0; i < 8; ++i) { const float x = src[(size_t)(8 * i) * w.Nlog]; v[i] = col >= 0 ? x : 0.f; }
}
__device__ __forceinline__ void wconv_phase(const Params& p, int l, int which, LAS unsigned char* lds) {
    constexpr int I0 = 16 * (NIN / 64), I1 = 16 * 16, I2 = 16 * (NF1 / 64), I3 = (DFF / 64) * 16;
    const int tot = ((which & 1) ? I0 : 0) + ((which & 2) ? I1 : 0) + ((which & 4) ? I2 : 0) + ((which & 8) ? I3 : 0);
    int tid_ = threadIdx.x; asm volatile("" : "+v"(tid_));
    const int tid = tid_;
    LAS float* tl = (LAS float*)lds;
    int it = blockIdx.x;
    if (it >= tot) return;
    WcItem cur = wc_decode(p, l, which, it);
    float v[8]; wc_load(cur, tid, v);
    for (;;) {
        const int nxt = it + gridDim.x; const bool has = nxt < tot;
        WcItem nw = cur; float vn[8];
        if (has) { nw = wc_decode(p, l, which, nxt); wc_load(nw, tid, vn); }
        { const int nn = tid & 63, kk = tid >> 6;
#pragma unroll
          for (int i = 0; i < 8; ++i) tl[(kk + 8 * i) * 65 + nn] = v[i]; }
        __syncthreads();
        { const int n = tid >> 3, c = tid & 7; const LAS float* s = tl + (8 * c) * 65 + n;
          u32x4 o; o.x = pk2(s[0], s[65]); o.y = pk2(s[2 * 65], s[3 * 65]); o.z = pk2(s[4 * 65], s[5 * 65]); o.w = pk2(s[6 * 65], s[7 * 65]);
          *(u32x4*)(cur.Wt + (size_t)(cur.n0 + n) * cur.K + cur.k0 + 8 * c) = o; }
        __syncthreads();
        if (!has) break;
        it = nxt; cur = nw;
#pragma unroll
        for (int i = 0; i < 8; ++i) v[i] = vn[i];
    }
}
__device__ __forceinline__ void wconv_dyn(const Params& p, int l, int which, unsigned* ctr, LAS unsigned char* lds) {
    constexpr int I0 = 16 * (NIN / 64), I1 = 16 * 16, I2 = 16 * (NF1 / 64), I3 = (DFF / 64) * 16;
    const int tot = ((which & 1) ? I0 : 0) + ((which & 2) ? I1 : 0) + ((which & 4) ? I2 : 0) + ((which & 8) ? I3 : 0);
    int tid_ = threadIdx.x; asm volatile("" : "+v"(tid_));
    const int tid = tid_;
    LAS float* tl = (LAS float*)lds;
    LAS int* slot = (LAS int*)(lds + LDS_BYTES - 16);
    for (;;) {
        if (tid == 0) *slot = (int)atomicAdd(ctr, 1u);
        __syncthreads();
        const int it = *slot;
        __syncthreads();
        if (it >= tot) break;
        const WcItem cur = wc_decode(p, l, which, it);
        float v[8]; wc_load(cur, tid, v);
        { const int nn = tid & 63, kk = tid >> 6;
#pragma unroll
          for (int i = 0; i < 8; ++i) tl[(kk + 8 * i) * 65 + nn] = v[i]; }
        __syncthreads();
        { const int n = tid >> 3, c = tid & 7; const LAS float* s = tl + (8 * c) * 65 + n;
          u32x4 o; o.x = pk2(s[0], s[65]); o.y = pk2(s[2 * 65], s[3 * 65]); o.z = pk2(s[4 * 65], s[5 * 65]); o.w = pk2(s[6 * 65], s[7 * 65]);
          *(u32x4*)(cur.Wt + (size_t)(cur.n0 + n) * cur.K + cur.k0 + 8 * c) = o; }
        __syncthreads();
    }
}
__device__ __forceinline__ void mod_phase(const Params& p, LAS unsigned char* lds) {
    LAS float* sc = (LAS float*)lds;
    LAS float* red = (LAS float*)(lds + 9 * 1024 * 4);
    float* mod = (float*)(p.ws + WS_MOD);
    int tid_ = threadIdx.x; asm volatile("" : "+v"(tid_));
    const int tid = tid_;
    constexpr int NIT = DEPTH * (MODW / 64);
    if ((int)blockIdx.x < NIT) {
        for (int i = tid; i < 9 * 1024; i += 512) { const float v = i < 8192 ? p.c[i] : p.c_ctx[i - 8192]; sc[i] = v / (1.0f + expf(-v)); }
        __syncthreads();
        for (int it = blockIdx.x; it < NIT; it += gridDim.x) {
            const int l = it / (MODW / 64), cb = it % (MODW / 64), j = tid & 63, kg = tid >> 6;
            const float* w = p.w_ada + (size_t)l * DM * MODW + cb * 64 + j;
            float a[9];
#pragma unroll
            for (int r = 0; r < 9; ++r) a[r] = 0.f;
#pragma unroll 16
            for (int k = kg * 128; k < kg * 128 + 128; ++k) { const float wv = w[(size_t)k * MODW];
#pragma unroll
                for (int r = 0; r < 9; ++r) a[r] += sc[r * 1024 + k] * wv; }
#pragma unroll
            for (int r = 0; r < 9; ++r) red[(kg * 9 + r) * 64 + j] = a[r];
            __syncthreads();
            if (tid < 64) { const float bv = p.b_ada[l * MODW + cb * 64 + j];
                for (int r = 0; r < 9; ++r) { float s = 0.f;
#pragma unroll
                    for (int g = 0; g < 8; ++g) s += red[(g * 9 + r) * 64 + j];
                    mod[((size_t)l * 9 + r) * MODW + cb * 64 + j] = s + bv; } }
            __syncthreads();
        }
    }
    if (blockIdx.x == gridDim.x - 1 && tid < 64) {
        float* lam = mod + (size_t)DEPTH * 9 * MODW;
        for (int l = 0; l < DEPTH; ++l) { const float* lv = p.dlam + l * 256;
            const float s01 = wave_sum(lv[tid] * lv[64 + tid]), s23 = wave_sum(lv[128 + tid] * lv[192 + tid]);
            if (tid == 0) { const float li = 0.8f - 0.6f * expf(-0.3f * (float)l); lam[2 * l] = expf(s01) - expf(s23) + li; lam[2 * l + 1] = li; } }
    }
}
__device__ __forceinline__ void init_rows_phase(const Params& p) {
    int tid_ = threadIdx.x; asm volatile("" : "+v"(tid_));
    const int lane = tid_ & 63, gw = blockIdx.x * 8 + (tid_ >> 6), NGW = gridDim.x * 8;
    float* X = (float*)(p.ws + WS_X); bf16_t* U = (bf16_t*)((unsigned char*)p.out + DO_U); const float* mod = (const float*)(p.ws + WS_MOD);
    for (int row0 = gw; row0 < MTOT; row0 += 2 * NGW) {
        f32x4 v[2][4]; int rows[2]; bool ok[2];
#pragma unroll
        for (int r = 0; r < 2; ++r) { const int rr = row0 + r * NGW; ok[r] = rr < MTOT; rows[r] = ok[r] ? rr : row0;
            const float* src = rows[r] < MLAT ? p.x + (size_t)rows[r] * DM : p.ctx + (size_t)(rows[r] - MLAT) * DM;
#pragma unroll
            for (int j = 0; j < 4; ++j) v[r][j] = *(const f32x4*)(src + 4 * lane + 256 * j); }
#pragma unroll
        for (int r = 0; r < 2; ++r) { if (!ok[r]) continue;
            const int row = rows[r]; const int bi = row < MLAT ? row / SEQ : 8;
            const float* sh = mod + (size_t)bi * MODW, *scp = sh + 1024;
#pragma unroll
            for (int j = 0; j < 4; ++j) { const int col = 4 * lane + 256 * j;
                const f32x4 s = *(const f32x4*)(scp + col), h = *(const f32x4*)(sh + col); const f32x4 u = v[r][j] * (s + 1.0f) + h;
                u32x2 w; w.x = pk2(u[0], u[1]); w.y = pk2(u[2], u[3]); *(u32x2*)(U + (size_t)row * DM + col) = w; } }
    }
}
__device__ __forceinline__ void ln_rows(const Params& p, const bf16_t* __restrict__ O, const float* gmod, const float* lng, const float* lnb, const float* nmod  ,
                                        float* outp, int lane, int row_first, int row_step, int row_end, const float* xin_lat = nullptr, const float* xin_ctx = nullptr) {
    float* X = (float*)(p.ws + WS_X); bf16_t* U = (bf16_t*)((unsigned char*)p.out + DO_U);
    for (int row0 = row_first; row0 < row_end; row0 += 2 * row_step) {
        f32x4 xv[2][4]; u32x2 ow[2][4]; int rows[2]; bool ok[2];
#pragma unroll
        for (int r = 0; r < 2; ++r) { const int rr = row0 + r * row_step; ok[r] = rr < row_end; rows[r] = ok[r] ? rr : row0;
#pragma unroll
            for (int j = 0; j < 4; ++j) { const int col = 4 * lane + 256 * j; const float* xs = xin_lat ? (rows[r] < MLAT ? xin_lat + (size_t)rows[r] * DM : xin_ctx + (size_t)(rows[r] - MLAT) * DM) : X + (size_t)rows[r] * DM; xv[r][j] = *(const f32x4*)(xs + col); ow[r][j] = *(const u32x2*)(O + (size_t)rows[r] * DM + col); } }
#pragma unroll
        for (int r = 0; r < 2; ++r) {
            const int row = rows[r]; const int bi = row < MLAT ? row / SEQ : 8;
            const float* g = gmod + (size_t)bi * MODW;
            f32x4 v[4]; float s = 0.f;
#pragma unroll
            for (int j = 0; j < 4; ++j) { const int col = 4 * lane + 256 * j; const f32x4 gv = *(const f32x4*)(g + col); f32x4 ov; ov[0] = bflo(ow[r][j].x); ov[1] = bfhi(ow[r][j].x); ov[2] = bflo(ow[r][j].y); ov[3] = bfhi(ow[r][j].y);
                v[j] = xv[r][j] * ALPHA + gv * ov; s += (v[j][0] + v[j][1]) + (v[j][2] + v[j][3]); }
            const float mean = wave_sum(s) * (1.0f / DM); float s2 = 0.f;
#pragma unroll
            for (int j = 0; j < 4; ++j) { v[j] = v[j] - mean; s2 += (v[j][0] * v[j][0] + v[j][1] * v[j][1]) + (v[j][2] * v[j][2] + v[j][3] * v[j][3]); }
            const float rstd = 1.0f / sqrtf(wave_sum(s2) * (1.0f / DM) + LN_EPS);
            if (ok[r]) {
#pragma unroll
                for (int j = 0; j < 4; ++j) { const int col = 4 * lane + 256 * j; const f32x4 y = v[j] * rstd * *(const f32x4*)(lng + col) + *(const f32x4*)(lnb + col);
                    if (outp) { *(f32x4*)(outp + (size_t)row * DM + col) = y; }
                    else { *(f32x4*)(X + (size_t)row * DM + col) = y;
                        const float* nm = nmod + (size_t)bi * MODW; const f32x4 u = y * (*(const f32x4*)(nm + 1024 + col) + 1.0f) + *(const f32x4*)(nm + col);
                        u32x2 w; w.x = pk2(u[0], u[1]); w.y = pk2(u[2], u[3]); *(u32x2*)(U + (size_t)row * DM + col) = w; } }
            }
        }
    }
}

constexpr int AT_KB = 9216;
#define MFMA32(a, b, c) __builtin_amdgcn_mfma_f32_32x32x16_bf16((a), (b), (c), 0, 0, 0)
__device__ __forceinline__ bf16x8 lds_rd16(const LAS unsigned char* p) { return *(const LAS bf16x8*)p; }
__device__ __forceinline__ bf16x8 lds_rd16v(const LAS unsigned char* p) { return *(const volatile LAS bf16x8*)p; }

__device__ __forceinline__ float max3f(float a, float b, float c) { float r; asm("v_max3_f32 %0, %1, %2, %3" : "=v"(r) : "v"(a), "v"(b), "v"(c)); return r; }
__device__ __forceinline__ float max2f(float a, float b) { float r; asm("v_max_f32_e32 %0, %1, %2" : "=v"(r) : "v"(a), "v"(b)); return r; }
__device__ __forceinline__ float rowmax32(const f32x16& a, const f32x16& b) {
    float m0 = max3f(a[0], a[1], b[0]), m1 = max3f(a[2], a[3], b[1]); m0 = max3f(m0, b[2], b[3]);
#pragma unroll
    for (int r = 4; r < 16; r += 4) { m0 = max3f(m0, a[r], a[r + 1]); m1 = max3f(m1, a[r + 2], a[r + 3]); m0 = max3f(m0, b[r], b[r + 1]); m1 = max3f(m1, b[r + 2], b[r + 3]); }
    const float m = max2f(m0, m1);
    auto rr = __builtin_amdgcn_permlane32_swap(__float_as_uint(m), __float_as_uint(m), false, false);
    return max2f(__uint_as_float(rr[0]), __uint_as_float(rr[1]));
}
constexpr int AT_K0 = 0, AT_V0 = 2 * AT_KB, AT_VB = 128 * 144;
template <int DV> struct AttnState {
    bf16x8 qr[4]; u32x4 kreg, vreg0, vreg1; f32x16 sc0, sc1, sd0, sd1, negm; f32x16 o[DV / 32]; float lsum, mrun;
    const bf16_t* kg; const bf16_t* vg; int kl, vl, koff, voff;
};
template <int DV, bool FULL>
__device__ __forceinline__ void attn_iter(AttnState<DV>& S, int t, int nt, LAS unsigned char* lds) {
    constexpr int NDB = DV / 32;
    const LAS unsigned char* BK = lds + AT_K0 + ((t + 1) & 1) * AT_KB;
    const LAS unsigned char* BV = lds + AT_V0 + (t & 1) * AT_VB;
    if (FULL || t + 2 < nt) *(LAS u32x4*)(lds + AT_K0 + (t & 1) * AT_KB + S.kl) = S.kreg;
    if (FULL || t + 1 < nt) { LAS unsigned char* W = lds + AT_V0 + ((t + 1) & 1) * AT_VB + S.vl; *(LAS u32x4*)W = S.vreg0; if (DV == 128) *(LAS u32x4*)(W + 64 * 144) = S.vreg1; }
    if (FULL || t + 3 < nt) S.kreg = *(const u32x4*)(S.kg + (size_t)(t + 3) * 4096);
    if (FULL || t + 2 < nt) { S.vreg0 = *(const u32x4*)(S.vg + (t + 2) * 64); if (DV == 128) S.vreg1 = *(const u32x4*)(S.vg + (size_t)64 * TK + (t + 2) * 64); }
    f32x16 sn0 = S.negm, sn1 = S.negm;
    if (FULL || t + 1 < nt) {
#pragma unroll
        for (int c = 0; c < 4; ++c) { const bf16x8 kf0 = lds_rd16(BK + S.koff + c * 32), kf1 = lds_rd16(BK + S.koff + 32 * 144 + c * 32);
            sn0 = MFMA32(kf0, S.qr[c], sn0); sn1 = MFMA32(kf1, S.qr[c], sn1); }
    }
    f32x16 p0, p1;
#pragma unroll
    for (int i = 0; i < 16; ++i) { p0[i] = fast_exp2(S.sc0[i]); p1[i] = fast_exp2(S.sc1[i]); }
    { const f32x16 s = p0 + p1; const f32x4 a = (f32x4){s[0], s[1], s[2], s[3]} + (f32x4){s[4], s[5], s[6], s[7]} + (f32x4){s[8], s[9], s[10], s[11]} + (f32x4){s[12], s[13], s[14], s[15]};
      S.lsum += (a[0] + a[1]) + (a[2] + a[3]); }
#pragma unroll
    for (int blk = 0; blk < 2; ++blk)
#pragma unroll
        for (int a = 0; a < 2; ++a) {
            u32x4 pw;
            if (blk == 0) { pw.x = pk2(p0[8 * a], p0[8 * a + 1]); pw.y = pk2(p0[8 * a + 2], p0[8 * a + 3]); pw.z = pk2(p0[8 * a + 4], p0[8 * a + 5]); pw.w = pk2(p0[8 * a + 6], p0[8 * a + 7]); }
            else { pw.x = pk2(p1[8 * a], p1[8 * a + 1]); pw.y = pk2(p1[8 * a + 2], p1[8 * a + 3]); pw.z = pk2(p1[8 * a + 4], p1[8 * a + 5]); pw.w = pk2(p1[8 * a + 6], p1[8 * a + 7]); }
            const bf16x8 pp = __builtin_bit_cast(bf16x8, pw);
#pragma unroll
            for (int d = 0; d < NDB; ++d) { const bf16x8 vf = lds_rd16(BV + S.voff + d * 32 * 144 + (32 * blk + 16 * a) * 2); S.o[d] = MFMA32(vf, pp, S.o[d]); }
        }
    float mx = 0.f;
    if (FULL || t + 1 < nt) mx = rowmax32(sn0, sn1);
    if (FULL || t + 1 < nt) {
        if (__any(mx > 8.0f)) {
            const float dl = fmaxf(mx, 0.f), alpha = fast_exp2(-dl);
            S.mrun += dl; S.lsum *= alpha;
#pragma unroll
            for (int i = 0; i < 16; ++i) { sn0[i] -= dl; sn1[i] -= dl; S.negm[i] = -S.mrun; }
#pragma unroll
            for (int d = 0; d < NDB; ++d)
#pragma unroll
                for (int i = 0; i < 16; ++i) S.o[d][i] *= alpha;
        }
    }
    S.sc0 = sn0; S.sc1 = sn1;
    __syncthreads();
}
template <int DV, int PAR>
__device__ __forceinline__ void attn_iter_full(AttnState<DV>& S, int t, LAS unsigned char* lds) {
    constexpr int NDB = DV / 32, NS = 8 + 4 * NDB, NU = 27;
    const LAS unsigned char* BK = lds + AT_K0 + (PAR ^ 1) * AT_KB + S.koff;
    const LAS unsigned char* BV = lds + AT_V0 + PAR * AT_VB + S.voff;
    f32x16& C0 = PAR ? S.sd0 : S.sc0; f32x16& C1 = PAR ? S.sd1 : S.sc1; f32x16& sn0 = PAR ? S.sc0 : S.sd0; f32x16& sn1 = PAR ? S.sc1 : S.sd1;
    sn0 = S.negm; sn1 = S.negm;
    u32x4 pw[4]; float mxa = 0.f, mxb = 0.f, mx = 0.f; f32x16 ssum;
    constexpr int PD = (DV == 64) ? 3 : 2; bf16x8 fr[PD + 1];
#define AT_FRAG(i) (((i) < 8) ? lds_rd16v(BK + ((i) & 1) * 32 * 144 + ((i) >> 1) * 32) \
                              : lds_rd16v(BV + (((i) - 8) % NDB) * 32 * 144 + (32 * ((((i) - 8) / NDB) >> 1) + 16 * ((((i) - 8) / NDB) & 1)) * 2))
#pragma unroll
    for (int i = 0; i < PD; ++i) fr[i] = AT_FRAG(i);
    __builtin_amdgcn_sched_barrier(0);
#pragma unroll
    for (int i = 0; i < NS; ++i) {
        if (i + PD < NS) fr[(i + PD) % (PD + 1)] = AT_FRAG(i + PD);
        if (i == 3) {
            *(LAS u32x4*)(lds + AT_K0 + PAR * AT_KB + S.kl) = S.kreg;
            LAS unsigned char* W = lds + AT_V0 + (PAR ^ 1) * AT_VB + S.vl; *(LAS u32x4*)W = S.vreg0; if (DV == 128) *(LAS u32x4*)(W + 64 * 144) = S.vreg1; }
        if (i == 5) { S.kreg = *(const u32x4*)(S.kg + (size_t)(t + 3) * 4096);
            S.vreg0 = *(const u32x4*)(S.vg + (t + 2) * 64); if (DV == 128) S.vreg1 = *(const u32x4*)(S.vg + (size_t)64 * TK + (t + 2) * 64); }
        if (i < 8) { if (i & 1) sn1 = MFMA32(fr[i % (PD + 1)], S.qr[i >> 1], sn1); else sn0 = MFMA32(fr[i % (PD + 1)], S.qr[i >> 1], sn0); }
        else { const int j = i - 8; S.o[j % NDB] = MFMA32(fr[i % (PD + 1)], __builtin_bit_cast(bf16x8, pw[j / NDB]), S.o[j % NDB]); }
#pragma unroll
        for (int u = 0; u < NU; ++u) {
            if (u * NS / NU != i) continue;
            if (u < 20) {
                const int q = u / 5, r = u % 5;
                if (r < 4) { const int e = 8 * q + 2 * r;
                    if (e < 16) { C0[e] = fast_exp2(C0[e]); C0[e + 1] = fast_exp2(C0[e + 1]); }
                    else { C1[e - 16] = fast_exp2(C1[e - 16]); C1[e - 15] = fast_exp2(C1[e - 15]); } }
                else { if (q < 2) { const int b0 = 8 * q; pw[q].x = pk2(C0[b0], C0[b0 + 1]); pw[q].y = pk2(C0[b0 + 2], C0[b0 + 3]); pw[q].z = pk2(C0[b0 + 4], C0[b0 + 5]); pw[q].w = pk2(C0[b0 + 6], C0[b0 + 7]); }
                       else { const int b0 = 8 * (q - 2); pw[q].x = pk2(C1[b0], C1[b0 + 1]); pw[q].y = pk2(C1[b0 + 2], C1[b0 + 3]); pw[q].z = pk2(C1[b0 + 4], C1[b0 + 5]); pw[q].w = pk2(C1[b0 + 6], C1[b0 + 7]); } }
            } else if (u == 20) { ssum = C0 + C1; }
            else if (u == 21) { const f32x4 a = (f32x4){ssum[0], ssum[1], ssum[2], ssum[3]} + (f32x4){ssum[4], ssum[5], ssum[6], ssum[7]} + (f32x4){ssum[8], ssum[9], ssum[10], ssum[11]} + (f32x4){ssum[12], ssum[13], ssum[14], ssum[15]};
                S.lsum += (a[0] + a[1]) + (a[2] + a[3]); }
            else if (u == 22) { mxa = max3f(sn0[0], sn0[1], sn1[0]); mxb = max3f(sn0[2], sn0[3], sn1[1]); mxa = max3f(mxa, sn1[2], sn1[3]); }
            else if (u < 26) { const int r = 4 * (u - 22); mxa = max3f(mxa, sn0[r], sn0[r + 1]); mxb = max3f(mxb, sn0[r + 2], sn0[r + 3]); mxa = max3f(mxa, sn1[r], sn1[r + 1]); mxb = max3f(mxb, sn1[r + 2], sn1[r + 3]); }
            else { const float m = max2f(mxa, mxb); auto rr = __builtin_amdgcn_permlane32_swap(__float_as_uint(m), __float_as_uint(m), false, false); mx = max2f(__uint_as_float(rr[0]), __uint_as_float(rr[1])); }
        }
        __builtin_amdgcn_sched_barrier(0);
    }
#undef AT_FRAG
    if (__any(mx > 8.0f)) {
        const float dl = fmaxf(mx, 0.f), alpha = fast_exp2(-dl);
        S.mrun += dl; S.lsum *= alpha;
#pragma unroll
        for (int i = 0; i < 16; ++i) { sn0[i] -= dl; sn1[i] -= dl; S.negm[i] = -S.mrun; }
#pragma unroll
        for (int d = 0; d < NDB; ++d)
#pragma unroll
            for (int i = 0; i < 16; ++i) S.o[d][i] *= alpha;
    }
    __syncthreads();
}
template <int DV>
__device__ __forceinline__ void attn_pass(const bf16_t* __restrict__ Qp, const bf16_t* __restrict__ Kp, const bf16_t* __restrict__ VTp, int nt,
                                          f32x16 (&o)[DV / 32], float& lout, LAS unsigned char* lds) {
    constexpr int NDB = DV / 32;
    int tid_ = threadIdx.x; asm volatile("" : "+v"(tid_));
    const int tid = tid_, lane = tid & 63, wid = tid >> 6, r32 = lane & 31, hi = lane >> 5;
    AttnState<DV> S;
    { const bf16_t* qrow = Qp + (size_t)(wid * 32 + r32) * 64 + hi * 8;
#pragma unroll
      for (int c = 0; c < 4; ++c) S.qr[c] = *(const bf16x8*)(qrow + c * 16); }
    const int lrow = tid >> 3, lseg = tid & 7;
    S.kg = Kp + (size_t)lrow * 64 + lseg * 8;
    S.vg = VTp + (size_t)lrow * TK + lseg * 8;
    S.kl = lrow * 144 + lseg * 16; S.vl = lrow * 144 + lseg * 16;
    const int kvr = (r32 & ~12) | (((r32 >> 2) & 1) << 3) | (((r32 >> 3) & 1) << 2);
    S.koff = kvr * 144 + hi * 16; S.voff = r32 * 144 + hi * 16;
    { const u32x4 k0 = *(const u32x4*)S.kg, k1 = *(const u32x4*)(S.kg + 4096), v0 = *(const u32x4*)S.vg;
      u32x4 v0b; if (DV == 128) v0b = *(const u32x4*)(S.vg + (size_t)64 * TK);
      *(LAS u32x4*)(lds + AT_K0 + S.kl) = k0; *(LAS u32x4*)(lds + AT_K0 + AT_KB + S.kl) = k1; *(LAS u32x4*)(lds + AT_V0 + S.vl) = v0; if (DV == 128) *(LAS u32x4*)(lds + AT_V0 + S.vl + 64 * 144) = v0b; }
    if (nt > 2) S.kreg = *(const u32x4*)(S.kg + (size_t)2 * 4096);
    S.vreg0 = *(const u32x4*)(S.vg + 64); if (DV == 128) S.vreg1 = *(const u32x4*)(S.vg + (size_t)64 * TK + 64);
    __syncthreads();
#pragma unroll
    for (int d = 0; d < NDB; ++d)
#pragma unroll
        for (int i = 0; i < 16; ++i) S.o[d][i] = 0.f;
    S.lsum = 0.f;
    {
        f32x16 s0, s1;
#pragma unroll
        for (int i = 0; i < 16; ++i) { s0[i] = 0.f; s1[i] = 0.f; }
#pragma unroll
        for (int c = 0; c < 4; ++c) { const bf16x8 kf0 = lds_rd16(lds + AT_K0 + S.koff + c * 32), kf1 = lds_rd16(lds + AT_K0 + S.koff + 32 * 144 + c * 32);
            s0 = MFMA32(kf0, S.qr[c], s0); s1 = MFMA32(kf1, S.qr[c], s1); }
        const float mx = rowmax32(s0, s1);
        S.mrun = mx;
#pragma unroll
        for (int i = 0; i < 16; ++i) { S.sc0[i] = s0[i] - mx; S.sc1[i] = s1[i] - mx; S.negm[i] = -mx; }
    }
    __syncthreads();
    int t = 0;
    for (; t + 4 < nt; t += 2) { attn_iter_full<DV, 0>(S, t, lds); attn_iter_full<DV, 1>(S, t + 1, lds); }
    for (; t < nt; ++t) attn_iter<DV, false>(S, t, nt, lds);
#pragma unroll
    for (int d = 0; d < NDB; ++d) o[d] = S.o[d];
    lout = S.lsum + __shfl_xor(S.lsum, 32);
}

__device__ __forceinline__ void diff_unit(const Params& p, int l, int b, int h, int qb, bool ctxq, LAS unsigned char* lds) {
    int tid_ = threadIdx.x; asm volatile("" : "+v"(tid_));
    const int lane = tid_ & 63, wid = tid_ >> 6, r32 = lane & 31, hi = lane >> 5;
    const bf16_t* Q1; const bf16_t* Q2; int nt; size_t yrow;
    if (ctxq) { Q1 = (const bf16_t*)(p.ws + WS_QDC) + (size_t)(b * 8 + 2 * h) * CTX * 64; Q2 = Q1 + (size_t)CTX * 64; nt = CTX / 64; yrow = (size_t)MLAT + b * CTX + wid * 32 + r32; }
    else { Q1 = (const bf16_t*)(p.ws + WS_QD) + ((size_t)(b * 8 + 2 * h) * SEQ + qb * 256) * 64; Q2 = Q1 + (size_t)SEQ * 64; nt = TK / 64; yrow = (size_t)b * SEQ + qb * 256 + wid * 32 + r32; }
    const bf16_t* K1 = (const bf16_t*)(p.ws + WS_KD) + (size_t)(b * 8 + 2 * h) * TK * 64; const bf16_t* K2 = K1 + (size_t)TK * 64;
    const bf16_t* VT = (const bf16_t*)(p.ws + WS_VDT) + (size_t)(b * 4 + h) * 128 * TK;
    const float* lamp = (const float*)(p.ws + WS_MOD) + (size_t)DEPTH * 9 * MODW + 2 * l;
    const float lam = lamp[0], lam_init = lamp[1];
    f32x16 o1[4], o2[4]; float l1, l2;
    LAS unsigned* stash = (LAS unsigned*)(lds + AT_V0 + 2 * AT_VB) + tid_;
    attn_pass<128>(Q1, K1, VT, nt, o1, l1, lds);
    { const float i1 = 1.0f / l1;
#pragma unroll
      for (int d = 0; d < 4; ++d)
#pragma unroll
          for (int i = 0; i < 8; ++i) stash[(d * 8 + i) * 512] = pk2(o1[d][2 * i] * i1, o1[d][2 * i + 1] * i1); }
    attn_pass<128>(Q2, K2, VT, nt, o2, l2, lds);
    const float c2 = lam / l2; float ss = 0.f;
#pragma unroll
    for (int d = 0; d < 4; ++d)
#pragma unroll
        for (int i = 0; i < 8; ++i) { const unsigned w = stash[(d * 8 + i) * 512]; o1[d][2 * i] = bflo(w) - c2 * o2[d][2 * i]; o1[d][2 * i + 1] = bfhi(w) - c2 * o2[d][2 * i + 1]; ss += o1[d][2 * i] * o1[d][2 * i] + o1[d][2 * i + 1] * o1[d][2 * i + 1]; }
    ss += __shfl_xor(ss, 32);
    const float r = __builtin_amdgcn_rsqf(ss * (1.0f / 128.0f) + LN_EPS) * (1.0f - lam_init);
    const float* gn = p.dnorm_g + l * 128;
    bf16_t* yp = (bf16_t*)(p.ws + WS_Y) + yrow * DM + 256 + h * 128;
#pragma unroll
    for (int d = 0; d < 4; ++d)
#pragma unroll
        for (int ig = 0; ig < 4; ++ig) { const int dd = 32 * d + 8 * ig + 4 * hi; const f32x4 g4 = *(const f32x4*)(gn + dd);
            u32x2 w; w.x = pk2(o1[d][4 * ig] * r * g4[0], o1[d][4 * ig + 1] * r * g4[1]); w.y = pk2(o1[d][4 * ig + 2] * r * g4[2], o1[d][4 * ig + 3] * r * g4[3]);
            *(u32x2*)(yp + dd) = w; }
}
__device__ __forceinline__ void gqa_unit(const Params& p, int b, int hq, int qb, bool ctxq, LAS unsigned char* lds) {
    int tid_ = threadIdx.x; asm volatile("" : "+v"(tid_));
    const int lane = tid_ & 63, wid = tid_ >> 6, r32 = lane & 31, hi = lane >> 5;
    const bf16_t* Q; int nt; size_t yrow;
    if (ctxq) { Q = (const bf16_t*)(p.ws + WS_QGC) + (size_t)(b * 4 + hq) * CTX * 64; nt = CTX / 64; yrow = (size_t)MLAT + b * CTX + wid * 32 + r32; }
    else { Q = (const bf16_t*)(p.ws + WS_QG) + ((size_t)(b * 4 + hq) * SEQ + qb * 256) * 64; nt = TK / 64; yrow = (size_t)b * SEQ + qb * 256 + wid * 32 + r32; }
    const int kvh = hq >> 1;
    const bf16_t* K = (const bf16_t*)(p.ws + WS_KG) + (size_t)(b * 2 + kvh) * TK * 64;
    const bf16_t* VT = (const bf16_t*)(p.ws + WS_VGT) + (size_t)(b * 2 + kvh) * 64 * TK;
    f32x16 o[2]; float ls;
    attn_pass<64>(Q, K, VT, nt, o, ls, lds);
    const float il = 1.0f / ls;
    bf16_t* yp = (bf16_t*)(p.ws + WS_Y) + yrow * DM + 768 + hq * 64;
#pragma unroll
    for (int d = 0; d < 2; ++d)
#pragma unroll
        for (int ig = 0; ig < 4; ++ig) { const int dd = 32 * d + 8 * ig + 4 * hi;
            u32x2 w; w.x = pk2(o[d][4 * ig] * il, o[d][4 * ig + 1] * il); w.y = pk2(o[d][4 * ig + 2] * il, o[d][4 * ig + 3] * il);
            *(u32x2*)(yp + dd) = w; }
}

constexpr int ML_QS = 0, ML_KS = 9216, ML_KT = 18432, ML_VT = 27648, ML_SW = 36864, ML_CT0 = 46080, ML_CT1 = 55296, ML_TAB = 64512, ML_GSZ = 67072;
constexpr int T_A = 0, T_BIGA = 256, T_WP = 512, T_U = 768, T_EMT = 1024, T_DP0 = 1280, T_DP1 = 1536, T_DI = 1792, T_NV0 = 2048, T_NV1 = 2304;
constexpr size_t ML_UNIT_BYTES = (size_t)3 * TK * 64 * 2 + (size_t)2 * TK * 16;

__device__ __forceinline__ void mlstm_unit(const Params& p, int l, int b, int h, LAS unsigned char* lds) {
    int tid_ = threadIdx.x; asm volatile("" : "+v"(tid_));
    const int tid = tid_, lane = tid & 63, wave = __builtin_amdgcn_readfirstlane(tid >> 6), g = wave >> 2, w4 = wave & 3, tid4 = tid & 255, r32 = lane & 31, hi = lane >> 5;
    LAS unsigned char* L = lds + g * ML_GSZ;
    const bf16_t* Pm = (const bf16_t*)(p.ws + WS_PM);
    const bf16_t* MVt = (const bf16_t*)(p.ws + WS_MVT) + (size_t)(b * 4 + h) * 64 * TK;
    const float* G = (const float*)(p.ws + WS_GATES);
    unsigned char* ub = p.ws + WS_ML + (size_t)(b * 4 + h) * ML_UNIT_BYTES;
    bf16_t* QA = (bf16_t*)ub; bf16_t* KA = QA + (size_t)TK * 64; bf16_t* KAT = KA + (size_t)TK * 64; f32x4* SC = (f32x4*)(KAT + (size_t)TK * 64);
    bf16_t* HX = (bf16_t*)((unsigned char*)p.out + (g ? DO_HB : DO_HF));
    const int ctxrow0 = MLAT + b * CTX, latrow0 = b * SEQ;
    for (int i = tid4; i < ML_GSZ / 16; i += 256) *(LAS u32x4*)(L + i * 16) = (u32x4){0u, 0u, 0u, 0u};
    {
        float wq[5], wk[5], bq, bk;
        { const float* cw = p.conv_w + (size_t)l * 5 * 512; const float* cb = p.conv_b + l * 512;
#pragma unroll
          for (int j = 0; j < 5; ++j) { wq[j] = cw[j * 512 + h * 64 + lane]; wk[j] = cw[j * 512 + 256 + h * 64 + lane]; }
          bq = cb[h * 64 + lane]; bk = cb[256 + h * 64 + lane]; }
#define PP_LOAD(gi_, QR, KR, MSK) do { const int tau0_ = (gi_) * 8; const bool isc_ = tau0_ < CTX; const int lo_ = isc_ ? 0 : CTX, hi_ = isc_ ? CTX : TK; MSK = 0u; \
            _Pragma("unroll") for (int i_ = 0; i_ < 12; ++i_) { const int tau_ = tau0_ - 2 + i_; const bool ok_ = tau_ >= lo_ && tau_ < hi_; const int tc_ = ok_ ? tau_ : tau0_; \
                const size_t row_ = tc_ < CTX ? (size_t)(ctxrow0 + tc_) : (size_t)(latrow0 + tc_ - CTX); const bf16_t* src_ = Pm + row_ * 768 + h * 64 + lane; QR[i_] = src_[0]; KR[i_] = src_[256]; MSK |= ok_ ? (1u << i_) : 0u; } } while (0)
        unsigned short qa_[12], ka_[12], qb_[12], kb_[12]; unsigned ma_ = 0u, mb_ = 0u;
        PP_LOAD(wave, qa_, ka_, ma_);
        for (int gi = wave; gi < TK / 8; gi += 8) {
            const int tau0 = gi * 8;
            if (gi + 8 < TK / 8) PP_LOAD(gi + 8, qb_, kb_, mb_);
            float qf[12], kf[12];
#pragma unroll
            for (int i = 0; i < 12; ++i) { const bool ok = (ma_ >> i) & 1u; qf[i] = ok ? bf2f(qa_[i]) : 0.f; kf[i] = ok ? bf2f(ka_[i]) : 0.f; }
            float ko[8];
#pragma unroll
            for (int i = 0; i < 8; ++i) { float qv = bq, kv = bk;
#pragma unroll
                for (int jj = 0; jj < 5; ++jj) { qv += wq[jj] * qf[i + jj]; kv += wk[jj] * kf[i + jj]; }
                const float qo = silu_f(qv) * 0.125f; ko[i] = silu_f(kv);
                QA[(size_t)(tau0 + i) * 64 + lane] = f2bf(qo); KA[(size_t)(tau0 + i) * 64 + lane] = f2bf(ko[i]); }
            u32x4 kt; kt.x = pk2(ko[0], ko[1]); kt.y = pk2(ko[2], ko[3]); kt.z = pk2(ko[4], ko[5]); kt.w = pk2(ko[6], ko[7]);
            *(u32x4*)(KAT + (size_t)lane * TK + tau0) = kt;
#pragma unroll
            for (int i = 0; i < 12; ++i) { qa_[i] = qb_[i]; ka_[i] = kb_[i]; }
            ma_ = mb_;
        }
#undef PP_LOAD
    }
    {
        float ipn, fpn;
#define PB_LOAD(it_, IP, FP) do { const int dir_ = (it_) >= 68, c_ = dir_ ? (it_) - 68 : (it_); const int tk_ = dir_ ? 63 - lane : lane; const int tau_ = c_ * 64 + tk_; \
            const size_t row_ = tau_ < CTX ? (size_t)(ctxrow0 + tau_) : (size_t)(latrow0 + tau_ - CTX); const float* gs_ = G + row_ * 16 + (dir_ ? 4 : 0) + h; IP = gs_[0]; FP = gs_[8]; } while (0)
        float ipc, fpc; PB_LOAD(wave, ipc, fpc);
        for (int it = wave; it < 136; it += 8) {
            if (it + 8 < 136) PB_LOAD(it + 8, ipn, fpn);
            const int dir = it >= 68, c = dir ? it - 68 : it; const int tk = dir ? 63 - lane : lane; const int tau = c * 64 + tk;
            const float ipre = ipc, fpre = fpc;
            const float lf = fminf(fpre, 0.f) - log1pf(expf(-fabsf(fpre)));
            float bc = lf;
#pragma unroll
            for (int d = 1; d < 64; d <<= 1) { const float y = __shfl_up(bc, d); if (lane >= d) bc += y; }
            const float av = ipre - bc;
            float cm = av;
#pragma unroll
            for (int d = 1; d < 64; d <<= 1) { const float y = __shfl_up(cm, d); if (lane >= d) cm = fmaxf(cm, y); }
            SC[(size_t)dir * TK + tau] = (f32x4){bc, av, cm, 0.f};
            ipc = ipn; fpc = fpn;
        }
#undef PB_LOAD
    }
    asm volatile("s_waitcnt vmcnt(0)" ::: "memory"); __syncthreads();
    const int tok = g ? 63 - lane : lane;
    f32x16 Cacc;
#pragma unroll
    for (int i = 0; i < 16; ++i) Cacc[i] = 0.f;
    float nreg = 0.f, mstate = 0.f;
    u32x4 rq0, rq1, rk0, rk1, rt0, rt1, rv0, rv1; f32x4 rsc;
#define CHUNK_OF(j) (g ? ((j) < 4 ? 3 - (j) : 71 - (j)) : (j))
#define ML_PREFETCH(j) do { const int c_ = CHUNK_OF(j); const int rr_ = tid4 >> 2, cc_ = (tid4 & 3) * 16; \
        { const bf16_t* s_ = QA + (size_t)(c_ * 64 + rr_) * 64 + cc_; rq0 = *(const u32x4*)s_; rq1 = *(const u32x4*)(s_ + 8); } \
        { const bf16_t* s_ = KA + (size_t)(c_ * 64 + rr_) * 64 + cc_; rk0 = *(const u32x4*)s_; rk1 = *(const u32x4*)(s_ + 8); } \
        { const bf16_t* s_ = KAT + (size_t)rr_ * TK + c_ * 64 + cc_; rt0 = *(const u32x4*)s_; rt1 = *(const u32x4*)(s_ + 8); } \
        { const bf16_t* s_ = MVt + (size_t)rr_ * TK + c_ * 64 + cc_; rv0 = *(const u32x4*)s_; rv1 = *(const u32x4*)(s_ + 8); } \
        rsc = SC[(size_t)g * TK + c_ * 64 + tok]; } while (0)
#define ML_BAR() asm volatile("s_waitcnt lgkmcnt(0)\n\ts_barrier" ::: "memory")
    ML_PREFETCH(0);
    int cur = 0;
    for (int j = 0; j < 68; ++j) {
        const int cidx = CHUNK_OF(j);
        const float bc = rsc[0], av = rsc[1], cm = rsc[2];
        const float Aq = fmaxf(cm, mstate);
        const float wp = fast_exp(mstate - Aq), emt = fast_exp(-(bc + Aq));
        const float A63 = __shfl(Aq, 63), bl = __shfl(bc, 63);
        const float uu = fast_exp(av - A63), decay = fast_exp(mstate - A63), mnext = bl + A63;
        if (w4 == 0) { LAS float* tb = (LAS float*)(L + ML_TAB); tb[T_A / 4 + tok] = av; tb[T_BIGA / 4 + tok] = Aq; tb[T_WP / 4 + tok] = wp; tb[T_U / 4 + tok] = uu; tb[T_EMT / 4 + tok] = emt; }
        { const int o_ = (tid4 >> 2) * 144 + (tid4 & 3) * 32;
          *(LAS u32x4*)(L + ML_QS + o_) = rq0; *(LAS u32x4*)(L + ML_QS + o_ + 16) = rq1; *(LAS u32x4*)(L + ML_KS + o_) = rk0; *(LAS u32x4*)(L + ML_KS + o_ + 16) = rk1;
          *(LAS u32x4*)(L + ML_KT + o_) = rt0; *(LAS u32x4*)(L + ML_KT + o_ + 16) = rt1; *(LAS u32x4*)(L + ML_VT + o_) = rv0; *(LAS u32x4*)(L + ML_VT + o_ + 16) = rv1; }
        if (j + 1 < 68) ML_PREFETCH(j + 1);
        ML_BAR();
        const LAS unsigned char* CTc = L + (cur ? ML_CT1 : ML_CT0); LAS unsigned char* CTn = L + (cur ? ML_CT0 : ML_CT1);
        const LAS float* tb = (const LAS float*)(L + ML_TAB);
        {
            const int sblk = w4 & 1, tblk = w4 >> 1;
            f32x16 st;
#pragma unroll
            for (int i = 0; i < 16; ++i) st[i] = 0.f;
#pragma unroll
            for (int c = 0; c < 4; ++c) { const bf16x8 af = lds_rd16(L + ML_KS + (32 * sblk + r32) * 144 + hi * 16 + c * 32), bfr = lds_rd16(L + ML_QS + (32 * tblk + r32) * 144 + hi * 16 + c * 32); st = MFMA32(af, bfr, st); }
            const int t = 32 * tblk + r32; const float At = tb[T_BIGA / 4 + t];
            float dsum = 0.f;
#pragma unroll
            for (int ig = 0; ig < 4; ++ig) { const int s0 = 32 * sblk + 8 * ig + 4 * hi; const f32x4 a4 = *(const LAS f32x4*)(L + ML_TAB + T_A + s0 * 4);
                float w[4];
#pragma unroll
                for (int e = 0; e < 4; ++e) { const int s = s0 + e; const bool valid = g ? (s >= t) : (s <= t); const float ex = fast_exp(fminf(a4[e] - At, 0.f)); w[e] = valid ? st[4 * ig + e] * ex : 0.f; dsum += w[e]; }
                u32x2 pw; pw.x = pk2(w[0], w[1]); pw.y = pk2(w[2], w[3]); *(LAS u32x2*)(L + ML_SW + t * 144 + s0 * 2) = pw; }
            dsum += __shfl_xor(dsum, 32);
            if (hi == 0) *(LAS float*)(L + ML_TAB + (sblk ? T_DP1 : T_DP0) + t * 4) = dsum;
        }
        {
            const int dblk = w4 & 1, vblk = w4 >> 1;
#pragma unroll
            for (int i = 0; i < 16; ++i) Cacc[i] *= decay;
#pragma unroll
            for (int c = 0; c < 4; ++c) { const bf16x8 af = lds_rd16(L + ML_KT + (32 * dblk + r32) * 144 + hi * 16 + c * 32);
                const u32x4 vv = *(const LAS u32x4*)(L + ML_VT + (32 * vblk + r32) * 144 + hi * 16 + c * 32);
                const f32x4 u0 = *(const LAS f32x4*)(L + ML_TAB + T_U + (16 * c + 8 * hi) * 4), u1 = *(const LAS f32x4*)(L + ML_TAB + T_U + (16 * c + 8 * hi + 4) * 4);
                u32x4 sv; sv.x = pk2(bflo(vv.x) * u0[0], bfhi(vv.x) * u0[1]); sv.y = pk2(bflo(vv.y) * u0[2], bfhi(vv.y) * u0[3]); sv.z = pk2(bflo(vv.z) * u1[0], bfhi(vv.z) * u1[1]); sv.w = pk2(bflo(vv.w) * u1[2], bfhi(vv.w) * u1[3]);
                Cacc = MFMA32(af, __builtin_bit_cast(bf16x8, sv), Cacc); }
#pragma unroll
            for (int ig = 0; ig < 4; ++ig) { const int d0 = 32 * dblk + 8 * ig + 4 * hi; u32x2 pw; pw.x = pk2(Cacc[4 * ig], Cacc[4 * ig + 1]); pw.y = pk2(Cacc[4 * ig + 2], Cacc[4 * ig + 3]);
                *(LAS u32x2*)(CTn + (32 * vblk + r32) * 144 + d0 * 2) = pw; }
        }
        if (w4 == 0) {
            float s = 0.f;
#pragma unroll
            for (int c = 0; c < 8; ++c) { const u32x4 v = *(const LAS u32x4*)(L + ML_KT + lane * 144 + c * 16); const f32x4 u0 = *(const LAS f32x4*)(L + ML_TAB + T_U + c * 32), u1 = *(const LAS f32x4*)(L + ML_TAB + T_U + c * 32 + 16);
                s += bflo(v.x) * u0[0] + bfhi(v.x) * u0[1] + bflo(v.y) * u0[2] + bfhi(v.y) * u0[3] + bflo(v.z) * u1[0] + bfhi(v.z) * u1[1] + bflo(v.w) * u1[2] + bfhi(v.w) * u1[3]; }
            nreg = decay * nreg + s;
            *(LAS float*)(L + ML_TAB + (cur ? T_NV0 : T_NV1) + lane * 4) = nreg;
        } else if (w4 == 1) {
            const LAS unsigned char* nv = L + ML_TAB + (cur ? T_NV1 : T_NV0); float s = 0.f;
#pragma unroll
            for (int c = 0; c < 8; ++c) { const u32x4 v = *(const LAS u32x4*)(L + ML_QS + lane * 144 + c * 16); const f32x4 n0 = *(const LAS f32x4*)(nv + c * 32), n1 = *(const LAS f32x4*)(nv + c * 32 + 16);
                s += bflo(v.x) * n0[0] + bfhi(v.x) * n0[1] + bflo(v.y) * n0[2] + bfhi(v.y) * n0[3] + bflo(v.z) * n1[0] + bfhi(v.z) * n1[1] + bflo(v.w) * n1[2] + bfhi(v.w) * n1[3]; }
            *(LAS float*)(L + ML_TAB + T_DI + lane * 4) = s;
        }
        ML_BAR();
        {
            const int tblk = w4 & 1, vblk = w4 >> 1;
            f32x16 a1, a2;
#pragma unroll
            for (int i = 0; i < 16; ++i) { a1[i] = 0.f; a2[i] = 0.f; }
#pragma unroll
            for (int c = 0; c < 4; ++c) { const bf16x8 bv = lds_rd16(L + ML_VT + (32 * vblk + r32) * 144 + hi * 16 + c * 32), as = lds_rd16(L + ML_SW + (32 * tblk + r32) * 144 + hi * 16 + c * 32);
                const bf16x8 aq = lds_rd16(L + ML_QS + (32 * tblk + r32) * 144 + hi * 16 + c * 32), bc2 = lds_rd16(CTc + (32 * vblk + r32) * 144 + hi * 16 + c * 32);
                a1 = MFMA32(as, bv, a1); a2 = MFMA32(aq, bc2, a2); }
            const int tau0 = cidx * 64; const size_t rowc = tau0 < CTX ? (size_t)(ctxrow0 + tau0) : (size_t)(latrow0 + tau0 - CTX);
            bf16_t* hp = HX + rowc * 256 + h * 64 + 32 * vblk + r32;
#pragma unroll
            for (int ig = 0; ig < 4; ++ig) { const int t0 = 32 * tblk + 8 * ig + 4 * hi;
                const f32x4 d0 = *(const LAS f32x4*)(L + ML_TAB + T_DP0 + t0 * 4), d1 = *(const LAS f32x4*)(L + ML_TAB + T_DP1 + t0 * 4), di = *(const LAS f32x4*)(L + ML_TAB + T_DI + t0 * 4),
                            w4v = *(const LAS f32x4*)(L + ML_TAB + T_WP + t0 * 4), em = *(const LAS f32x4*)(L + ML_TAB + T_EMT + t0 * 4);
#pragma unroll
                for (int e = 0; e < 4; ++e) { const float den = d0[e] + d1[e] + w4v[e] * di[e]; const float dn = fmaxf(fabsf(den), em[e]);
                    const float hv = (a1[4 * ig + e] + w4v[e] * a2[4 * ig + e]) * fast_rcp(dn); hp[(size_t)(t0 + e) * 256] = f2bf(hv); } }
        }
        mstate = mnext; cur ^= 1;
        ML_BAR();
    }
#undef ML_PREFETCH
#undef ML_BAR
#undef CHUNK_OF
    asm volatile("s_waitcnt vmcnt(0)" ::: "memory"); __syncthreads();
    {
        const bf16_t* HF = (const bf16_t*)((unsigned char*)p.out + DO_HF); const bf16_t* HB = (const bf16_t*)((unsigned char*)p.out + DO_HB);
        bf16_t* Y = (bf16_t*)(p.ws + WS_Y);
        const int seg = tid & 3; const float* gp = p.mnorm_g + l * 256 + h * 64 + seg * 16;
        float gg[16];
#pragma unroll
        for (int i = 0; i < 16; ++i) gg[i] = gp[i];
        for (int it = 0; it < TK / 128; it += 2) {
            size_t rows[2]; u32x4 fa[2], fb[2], ba[2], bb[2], oa[2], ob[2];
#pragma unroll
            for (int r = 0; r < 2; ++r) { const int idx = (it + r) * 128 + (tid >> 2); rows[r] = idx < SEQ ? (size_t)b * SEQ + idx : (size_t)MLAT + b * CTX + (idx - SEQ);
                const size_t row = rows[r];
                fa[r] = *(const u32x4*)(HF + row * 256 + h * 64 + seg * 16); fb[r] = *(const u32x4*)(HF + row * 256 + h * 64 + seg * 16 + 8);
                ba[r] = *(const u32x4*)(HB + row * 256 + h * 64 + seg * 16); bb[r] = *(const u32x4*)(HB + row * 256 + h * 64 + seg * 16 + 8);
                oa[r] = *(const u32x4*)(Pm + row * 768 + 512 + h * 64 + seg * 16); ob[r] = *(const u32x4*)(Pm + row * 768 + 512 + h * 64 + seg * 16 + 8); }
#pragma unroll
            for (int r = 0; r < 2; ++r) {
                float v[16], og[16];
                const unsigned fw[8] = {fa[r].x, fa[r].y, fa[r].z, fa[r].w, fb[r].x, fb[r].y, fb[r].z, fb[r].w}, bw[8] = {ba[r].x, ba[r].y, ba[r].z, ba[r].w, bb[r].x, bb[r].y, bb[r].z, bb[r].w},
                               ow[8] = {oa[r].x, oa[r].y, oa[r].z, oa[r].w, ob[r].x, ob[r].y, ob[r].z, ob[r].w};
                float sm = 0.f;
#pragma unroll
                for (int i = 0; i < 8; ++i) { v[2 * i] = bflo(fw[i]) + bflo(bw[i]); v[2 * i + 1] = bfhi(fw[i]) + bfhi(bw[i]); og[2 * i] = bflo(ow[i]); og[2 * i + 1] = bfhi(ow[i]); sm += v[2 * i] + v[2 * i + 1]; }
                sm += __shfl_xor(sm, 1); sm += __shfl_xor(sm, 2);
                const float mu = sm * (1.0f / 64.0f); float s2 = 0.f;
#pragma unroll
                for (int i = 0; i < 16; ++i) { v[i] -= mu; s2 += v[i] * v[i]; }
                s2 += __shfl_xor(s2, 1); s2 += __shfl_xor(s2, 2);
                const float rstd = 1.0f / sqrtf(s2 * (1.0f / 64.0f) + LN_EPS);
                unsigned wv[8];
#pragma unroll
                for (int i = 0; i < 8; ++i) wv[i] = pk2(v[2 * i] * rstd * gg[2 * i] * sigmoid_f(og[2 * i]), v[2 * i + 1] * rstd * gg[2 * i + 1] * sigmoid_f(og[2 * i + 1]));
                bf16_t* yp = Y + rows[r] * DM + h * 64 + seg * 16;
                *(u32x4*)yp = (u32x4){wv[0], wv[1], wv[2], wv[3]}; *(u32x4*)(yp + 8) = (u32x4){wv[4], wv[5], wv[6], wv[7]}; }
        }
    }
}

#ifndef PHM
#define PHM 63
#endif
__device__ __forceinline__ unsigned xcc_id() { return (unsigned)__builtin_amdgcn_s_getreg((3 << 11) | 20) & 7u; }
__device__ __forceinline__ void mixer_phase(const Params& p, int l, bool last, LAS unsigned char* lds) {
    unsigned* ctr = (unsigned*)(p.ws + WS_CTL) + 64 * (l + 1);
    LAS int* slot = (LAS int*)(lds + LDS_BYTES - 16);
    const int nper = last ? 132 : 140;
    int q = (int)xcc_id(), tried = 0;
    for (;;) {
        if (threadIdx.x == 0) {
            int it = -1;
            while (tried < 8) { const int v = (int)atomicAdd(ctr + q, 1u); if (v < nper) { it = (q << 8) | v; break; } q = (q + 1) & 7; ++tried; }
            *slot = it;
        }
        __syncthreads();
        const int code = *slot;
        __syncthreads();
        if (code < 0) break;
        const int x = code >> 8; int it = code & 255;
        if (it < 4) { const int m = x * 4 + it; if (PHM & 1) mlstm_unit(p, l, m >> 2, m & 3, lds); }
        else if ((it -= 4) < 64) { const int pr = x + 8 * (it >> 4); if (PHM & 2) diff_unit(p, l, pr >> 2, pr & 3, it & 15, false, lds); }
        else if ((it -= 64) < 64) { const int k = x + 8 * (it >> 5); if (PHM & 4) gqa_unit(p, k >> 1, (k & 1) * 2 + ((it >> 4) & 1), it & 15, false, lds); }
        else if ((it -= 64) < 4) { const int pr = x + 8 * it; if (PHM & 2) diff_unit(p, l, pr >> 2, pr & 3, 0, true, lds); }
        else { it -= 4; const int idx = x + 8 * it; if (PHM & 4) gqa_unit(p, idx >> 2, idx & 3, 0, true, lds); }
        __syncthreads();
    }
    if (!last) wconv_dyn(p, l + 1, 15, (unsigned*)(p.ws + WS_CTL) + 620 + l, lds);
}

__device__ __forceinline__ void ln_ctx_phase(const Params& p, int l, bool last, int which, const bf16_t* A, const bf16_t* Bt, int K, bf16_t* O, const float* gmod, const float* lng, const float* lnb,
                                             const float* nmod, float* outp, unsigned* ctl, LAS unsigned char* lds, const float* xin_lat = nullptr, const float* xin_ctx = nullptr) {
    int tid_ = threadIdx.x; asm volatile("" : "+v"(tid_));
    const int lane = tid_ & 63, wave = tid_ >> 6;
    if (last) { ln_rows(p, O, gmod, lng, lnb, nmod, outp, lane, blockIdx.x * 8 + wave, gridDim.x * 8, MLAT, xin_lat, xin_ctx); return; }
    if (blockIdx.x < 32) {
        const int pm = 128 + ((int)blockIdx.x >> 2), pn = (int)blockIdx.x & 3;
        unsigned* cnt = ctl + 8192 + (l * 2 + which) * 8 + (pm - 128);
        { pg8::Gemm g{A, Bt, MTOT, DM, K}; pg8::SingleOrder S{pm, pn, cnt}; pg8::EpiPlain E{O, DM};
          pg8::gemm_phase<pg8::EpiPlain, pg8::SingleOrder, true, true>(lds, g, S, E); }
        if (tid_ == 0) { while (__hip_atomic_load(cnt, __ATOMIC_RELAXED, __HIP_MEMORY_SCOPE_AGENT) < 32u) __builtin_amdgcn_s_sleep(8); }
        __syncthreads();
        __builtin_amdgcn_fence(__ATOMIC_ACQUIRE, "agent");
        const int base = pm * 256 + pn * 64 + wave * 8;
        ln_rows(p, O, gmod, lng, lnb, nmod, outp, lane, base, 1, base + 8, xin_lat, xin_ctx);
    } else {
        ln_rows(p, O, gmod, lng, lnb, nmod, outp, lane, ((int)blockIdx.x - 32) * 8 + wave, ((int)gridDim.x - 32) * 8, MLAT, xin_lat, xin_ctx);
    }
}

__global__ void __launch_bounds__(512, 2) fwd_megakernel(Params p) {
    extern __shared__ __attribute__((aligned(16))) unsigned char lds_raw[];
    LAS unsigned char* lds = (LAS unsigned char*)lds_raw;
    cg::grid_group grid = cg::this_grid();
    if (threadIdx.x < 16) ((LAS unsigned*)(lds + LDS_BYTES - 64))[threadIdx.x] = 0u;
    __syncthreads();
    const XcdBarrier xb = xcd_barrier_post((unsigned*)(p.ws + WS_CTL) + 4096, (volatile LAS unsigned*)(lds + LDS_BYTES - 64));
    const float* mod = (const float*)(p.ws + WS_MOD);
    unsigned* ctl = (unsigned*)(p.ws + WS_CTL);
    bf16_t* U = (bf16_t*)((unsigned char*)p.out + DO_U);
    mod_phase(p, lds);
    __syncthreads();
    wconv_phase(p, 0, 15, lds);
    grid.sync();
    init_rows_phase(p);
    xcd_barrier(xb);
    for (int l = 0; l < DEPTH; ++l) {
        const bool last = (l == DEPTH - 1);
        const int Mrows = last ? MLAT : MTOT;
        const float* modl = mod + (size_t)l * 9 * MODW;
        {
            pg8::Gemm g{U, (const bf16_t*)(p.ws + WS_WIN), MTOT, NIN, DM}; pg8::StaticOrder S; S.init(MTOT, NIN, gridDim.x, (int)blockIdx.x);
            pg8::EpiIn E{(bf16_t*)(p.ws + WS_PM), (bf16_t*)(p.ws + WS_MVT), (bf16_t*)(p.ws + WS_QD), (bf16_t*)(p.ws + WS_QDC), (bf16_t*)(p.ws + WS_KD), (bf16_t*)(p.ws + WS_VDT),
                         (bf16_t*)(p.ws + WS_QG), (bf16_t*)(p.ws + WS_QGC), (bf16_t*)(p.ws + WS_KG), (bf16_t*)(p.ws + WS_VGT), (float*)(p.ws + WS_GATES),
                         p.gate_b + l * 16, p.qn_g + l * 64, p.kn_g + l * 64};
            if (PHM & 8) pg8::gemm_phase<pg8::EpiIn, pg8::StaticOrder, true, true>(lds, g, S, E);
        }
        xcd_barrier(xb);
        mixer_phase(p, l, last, lds);
        xcd_barrier(xb);
        {
            pg8::Gemm g{(const bf16_t*)(p.ws + WS_Y), (const bf16_t*)(p.ws + ((l & 1) ? WS_WOUTB : WS_WOUT)), MLAT, DM, DM}; pg8::StaticOrder S; S.init(MLAT, DM, gridDim.x, (int)blockIdx.x);
            pg8::EpiPlain E{(bf16_t*)(p.ws + WS_O1), DM};
            if (PHM & 32) pg8::gemm_phase<pg8::EpiPlain, pg8::StaticOrder, true, true>(lds, g, S, E);
        }
        xcd_barrier(xb);
        ln_ctx_phase(p, l, last, 0, (const bf16_t*)(p.ws + WS_Y), (const bf16_t*)(p.ws + ((l & 1) ? WS_WOUTB : WS_WOUT)), DM, (bf16_t*)(p.ws + WS_O1), modl + 2048, p.ln1_g + l * DM, p.ln1_b + l * DM, modl + 3072, nullptr, ctl, lds, l == 0 ? p.x : nullptr, l == 0 ? p.ctx : nullptr);
        xcd_barrier(xb);
        {
            pg8::Gemm g{U, (l & 1) ? (const bf16_t*)((unsigned char*)p.out + DO_WF1B) : (const bf16_t*)(p.ws + WS_WF1), Mrows, NF1, DM}; pg8::StaticOrder S; S.init(Mrows, NF1, gridDim.x, (int)blockIdx.x);
            pg8::EpiSwiglu E{(bf16_t*)(p.ws + WS_H)};
            if (PHM & 16) pg8::gemm_phase<pg8::EpiSwiglu, pg8::StaticOrder, true, true>(lds, g, S, E);
        }
        xcd_barrier(xb);
        {
            pg8::Gemm g{(const bf16_t*)(p.ws + WS_H), (const bf16_t*)(p.ws + ((l & 1) ? WS_WF2B : WS_WF2)), MLAT, DM, DFF}; pg8::StaticOrder S; S.init(MLAT, DM, gridDim.x, (int)blockIdx.x);
            pg8::EpiPlain E{(bf16_t*)(p.ws + WS_O2), DM};
            if (PHM & 32) pg8::gemm_phase<pg8::EpiPlain, pg8::StaticOrder, true, true>(lds, g, S, E);
        }
        xcd_barrier(xb);
        ln_ctx_phase(p, l, last, 1, (const bf16_t*)(p.ws + WS_H), (const bf16_t*)(p.ws + ((l & 1) ? WS_WF2B : WS_WF2)), DFF, (bf16_t*)(p.ws + WS_O2), modl + 5120, p.ln2_g + l * DM, p.ln2_b + l * DM, last ? nullptr : (modl + 9 * MODW), last ? p.out : nullptr, ctl, lds);
        if (!last) { xcd_barrier(xb); }
    }
}

extern "C" void kernel_launch(void* const* d_in, const int* in_sizes, int n_in, void* d_out, int out_size, void* d_ws, size_t ws_size, hipStream_t stream) {
    static int grid = 0;
    if (grid == 0) {
        if (n_in != 22 || out_size != MLAT * DM || ws_size < WS_END) { fprintf(stderr, "kernel_launch: unexpected shapes (n_in %d, out %d, ws %zu)\n", n_in, out_size, ws_size); grid = -1; return; }
        int dev = 0, cus = 0, per_cu = 0;
        hipGetDevice(&dev); hipDeviceGetAttribute(&cus, hipDeviceAttributeMultiprocessorCount, dev);
        if (hipFuncSetAttribute((const void*)fwd_megakernel, hipFuncAttributeMaxDynamicSharedMemorySize, LDS_BYTES) != hipSuccess) { fprintf(stderr, "kernel_launch: hipFuncSetAttribute failed\n"); grid = -1; return; }
        if (hipOccupancyMaxActiveBlocksPerMultiprocessor(&per_cu, (const void*)fwd_megakernel, 512, LDS_BYTES) != hipSuccess || per_cu < 1) { fprintf(stderr, "kernel_launch: occupancy query says %d\n", per_cu); per_cu = 1; }
        (void)hipGetLastError();
        grid = cus * 1;
    }
    if (grid < 0) return;
    hipMemsetAsync((char*)d_ws + WS_CTL, 0, 65536, stream);
    Params p{};
    const float** f = (const float**)&p;
    for (int i = 0; i < 22; ++i) f[i] = (const float*)d_in[i];
    p.out = (float*)d_out; p.ws = (unsigned char*)d_ws;
    void* args[] = {&p};
    hipError_t e = hipLaunchCooperativeKernel((const void*)fwd_megakernel, dim3(grid), dim3(512), args, LDS_BYTES, stream);
    if (e != hipSuccess) fprintf(stderr, "cooperative launch failed: %s (grid %d)\n", hipGetErrorString(e), grid);
}
```

```cpp
#include <hip/hip_runtime.h>
#include <hip/hip_cooperative_groups.h>
#include <cstdio>
#include <cstdint>
namespace cg = cooperative_groups;

#define LAS __attribute__((address_space(3)))
typedef unsigned short bf16_t;
typedef short bf16x8 __attribute__((ext_vector_type(8)));
typedef float f32x4 __attribute__((ext_vector_type(4)));
typedef float f32x16 __attribute__((ext_vector_type(16)));
typedef unsigned u32x4 __attribute__((ext_vector_type(4)));
typedef unsigned u32x2 __attribute__((ext_vector_type(2)));
typedef float f32x2_t __attribute__((ext_vector_type(2)));
typedef __bf16 bf16x2_t __attribute__((ext_vector_type(2)));

__device__ __forceinline__ unsigned pk2(float lo, float hi) { f32x2_t v = {lo, hi}; bf16x2_t b = __builtin_convertvector(v, bf16x2_t); return __builtin_bit_cast(unsigned, b); }
__device__ __forceinline__ bf16_t f2bf(float f) { return (bf16_t)(pk2(f, 0.f) & 0xffffu); }
__device__ __forceinline__ float bf2f(unsigned short h) { return __uint_as_float(((unsigned)h) << 16); }
__device__ __forceinline__ float bflo(unsigned w) { return __uint_as_float(w << 16); }
__device__ __forceinline__ float bfhi(unsigned w) { return __uint_as_float(w & 0xffff0000u); }
__device__ __forceinline__ float fast_exp2(float x) { return __builtin_amdgcn_exp2f(x); }
__device__ __forceinline__ float fast_exp(float x) { return __builtin_amdgcn_exp2f(x * 1.4426950408889634f); }
__device__ __forceinline__ float fast_rcp(float x) { return __builtin_amdgcn_rcpf(x); }
__device__ __forceinline__ float silu_f(float x) { return x * fast_rcp(1.0f + fast_exp(-x)); }
__device__ __forceinline__ float sigmoid_f(float x) { return fast_rcp(1.0f + fast_exp(-x)); }

constexpr int DM = 1024, NB = 8, SEQ = 4096, CTX = 256, DEPTH = 4, TK = SEQ + CTX;
constexpr int MLAT = NB * SEQ, MCTX = NB * CTX, MTOT = MLAT + MCTX;
constexpr int NIN = 3328, INCOLS = 3088, DFF = 2816, NF1 = 2 * DFF;
constexpr float LN_EPS = 1e-5f;
constexpr float ALPHA = 1.681792830507429f;
constexpr float QSC = 0.125f * 1.4426950408889634f;

constexpr size_t MiB = 1u << 20;
constexpr size_t WS_CTL = 0, WS_MOD = 1 * MiB, WS_WIN = 2 * MiB, WS_WOUT = 9 * MiB, WS_WF1 = 11 * MiB, WS_WF2 = 22 * MiB, WS_GATES = 28 * MiB, WS_X = 32 * MiB;
constexpr size_t WS_A = 168 * MiB;
constexpr size_t WS_PM = WS_A, WS_MVT = WS_A + 51 * MiB, WS_QD = WS_A + 68 * MiB, WS_QDC = WS_A + 100 * MiB, WS_KD = WS_A + 102 * MiB, WS_VDT = WS_A + 136 * MiB,
                 WS_QG = WS_A + 170 * MiB, WS_QGC = WS_A + 186 * MiB, WS_KG = WS_A + 187 * MiB, WS_VGT = WS_A + 196 * MiB, WS_Y = WS_A + 206 * MiB;
constexpr size_t WS_H = WS_A, WS_O1 = WS_A, WS_O2 = WS_Y, WS_WF2B = WS_Y + 68 * MiB, WS_ML = WS_WF2B + 6 * MiB, WS_WOUTB = WS_ML + 56 * MiB, WS_END = WS_WOUTB + 2 * MiB;
constexpr size_t DO_U = 0, DO_HF = 68 * MiB, DO_HB = 85 * MiB, DO_WF1B = 102 * MiB;
constexpr int MODW = 6 * DM;
constexpr int LDS_BYTES = 147456;

struct Params {
  const float *x, *c, *ctx, *c_ctx, *w_ada, *b_ada, *w_in, *conv_w, *conv_b, *gate_b, *mnorm_g, *dlam, *dnorm_g, *qn_g, *kn_g, *w_out, *ln1_g, *ln1_b, *w_f1, *w_f2, *ln2_g, *ln2_b;
  float* out; unsigned char* ws;
};
namespace pg8 {
#define PG8_LAS __attribute__((address_space(3)))
typedef unsigned short bf16_t;
typedef short bf16x8 __attribute__((ext_vector_type(8)));
typedef float f32x4 __attribute__((ext_vector_type(4)));
typedef unsigned u32x4 __attribute__((ext_vector_type(4)));
constexpr int BM = 256, BK = 64, HALF = 128, HTB = HALF * BK * 2  , STAGE_BYTES = 8 * HTB, NXCD = 8, WGM = 8;

__host__ __device__ __forceinline__ int lds_byte(int r, int c) { const int st = (r >> 4) * 2 + (c >> 5), rr = r & 15, cc = c & 31, ob = rr * 64 + cc * 2; return st * 1024 + (ob ^ (((ob >> 9) & 1) << 5)); }
__host__ __device__ __forceinline__ void stage_rc(int b, int& R, int& C) { const int st = b / 1024, sb = b % 1024, swz = sb ^ (((sb >> 9) & 1) << 5); R = (st >> 1) * 16 + swz / 64; C = (st & 1) * 32 + (swz % 64) / 2; }
__host__ __device__ __forceinline__ int perm32(int rho) { const int n = rho >> 4, i = rho & 15; return 8 * (i >> 2) + 4 * n + (i & 3); }

struct Unit { int pm, pn; };
struct Gemm { const bf16_t* A; const bf16_t* Bt; int M, N, K; };

struct StaticOrder {
    int nM, nN, nwg, G, c;
    __host__ __device__ void init(int M, int N, int G_, int c_) { nM = M / BM; nN = N / BM; nwg = nM * nN; G = G_; c = c_; }
    __host__ __device__ bool next(int i, Unit& u) const {
        const long L = (long)i * G + c; if (L >= nwg) return false;
        int wgid = (int)L; { const int q = nwg / NXCD, r = nwg % NXCD, xcd = wgid % NXCD, off = wgid / NXCD; wgid = (xcd < r ? xcd * (q + 1) : r * (q + 1) + (xcd - r) * q) + off; }
        const int nig = WGM * nN, gid = wgid / nig, fm = gid * WGM, gsz = (nM - fm) < WGM ? (nM - fm) : WGM;
        u.pm = fm + ((wgid % nig) % gsz); u.pn = (wgid % nig) / gsz; return true;
    }
    __device__ __forceinline__ void a_ready(const Unit&) const {}
    __device__ __forceinline__ void done(const Unit&) const {}
};

struct EpiPlain {
    static constexpr bool PERM = true, AFTER_DRAIN = false;
    bf16_t* O; int ldc;
    __device__ __forceinline__ void operator()(const f32x4 (&acc)[2][2][4][2], const Unit& u, int wr, int wc, int fr, int fq) const {
        const int row0 = u.pm * BM + wr * 64 + fr, col0 = u.pn * BM + wc * 32 + 8 * fq;
#pragma unroll
        for (int ai = 0; ai < 2; ++ai)
#pragma unroll
            for (int m = 0; m < 4; ++m) { bf16_t* rowp = O + (size_t)(row0 + ai * HALF + m * 16) * ldc + col0;
#pragma unroll
                for (int bj = 0; bj < 2; ++bj) { const f32x4 v0 = acc[ai][bj][m][0], v1 = acc[ai][bj][m][1];
                    u32x4 w; w.x = ::pk2(v0[0], v0[1]); w.y = ::pk2(v0[2], v0[3]); w.z = ::pk2(v1[0], v1[1]); w.w = ::pk2(v1[2], v1[3]);
                    *(u32x4*)(rowp + bj * HALF) = w; } }
    }
};
struct EpiSwiglu {
    static constexpr bool PERM = true, AFTER_DRAIN = false;
    bf16_t* H;
    __device__ __forceinline__ void operator()(const f32x4 (&acc)[2][2][4][2], const Unit& u, int wr, int wc, int fr, int fq) const {
        const int row0 = u.pm * BM + wr * 64 + fr, col0 = u.pn * 128 + wc * 32 + 8 * fq;
#pragma unroll
        for (int ai = 0; ai < 2; ++ai)
#pragma unroll
            for (int m = 0; m < 4; ++m) { bf16_t* rowp = H + (size_t)(row0 + ai * HALF + m * 16) * ::DFF + col0;
                const f32x4 g0 = acc[ai][0][m][0], g1 = acc[ai][0][m][1], u0 = acc[ai][1][m][0], u1 = acc[ai][1][m][1];
                float h[8];
#pragma unroll
                for (int e = 0; e < 4; ++e) { h[e] = ::silu_f(g0[e]) * u0[e]; h[4 + e] = ::silu_f(g1[e]) * u1[e]; }
                u32x4 w; w.x = ::pk2(h[0], h[1]); w.y = ::pk2(h[2], h[3]); w.z = ::pk2(h[4], h[5]); w.w = ::pk2(h[6], h[7]);
                *(u32x4*)rowp = w; }
    }
};
struct EpiIn {
    static constexpr bool PERM = true, AFTER_DRAIN = false;
    bf16_t *Pm, *MVt, *Qd, *Qdc, *Kd, *VdT, *Qg, *Qgc, *Kg, *VgT; float* G; const float *gate_b, *qn_g, *kn_g;
    __device__ __forceinline__ void operator()(const f32x4 (&acc)[2][2][4][2], const Unit& u, int wr, int wc, int fr, int fq) const {
        const int ch = u.pn * 4 + wc;
        if (ch > 48) return;
        const bool is_ctx = u.pm >= 128;
        const int b = is_ctx ? (u.pm - 128) : (u.pm >> 4);
        int tbase = (is_ctx ? 0 : (u.pm & 15) * 256) + wr * 64 + fr;
        asm volatile("" : "+v"(tbase));
        const int rowbase = u.pm * BM + wr * 64 + fr;
        if (ch == 48) {
            const f32x4 gb = *(const f32x4*)(gate_b + 4 * fq);
#pragma unroll
            for (int ai = 0; ai < 2; ++ai)
#pragma unroll
                for (int m = 0; m < 4; ++m) *(f32x4*)(G + (size_t)(rowbase + ai * HALF + m * 16) * 16 + 4 * fq) = acc[ai][0][m][0] + gb;
            return;
        }
        if (ch < 8 || (ch >= 12 && ch < 16)) {
            const int cb = (ch < 8 ? ch * 64 : 512 + (ch - 12) * 64) + 4 * fq;
#pragma unroll
            for (int ai = 0; ai < 2; ++ai)
#pragma unroll
                for (int m = 0; m < 4; ++m) { bf16_t* rp = Pm + (size_t)(rowbase + ai * HALF + m * 16) * 768 + cb;
#pragma unroll
                    for (int bj = 0; bj < 2; ++bj)
#pragma unroll
                        for (int n = 0; n < 2; ++n) { const f32x4 v = acc[ai][bj][m][n]; u32x2 w; w.x = ::pk2(v[0], v[1]); w.y = ::pk2(v[2], v[3]); *(u32x2*)(rp + 32 * bj + 16 * n) = w; } }
            return;
        }
        if ((ch >= 8 && ch < 12) || (ch >= 32 && ch < 40) || ch >= 46) {
            bf16_t* base; int doff = 0;
            if (ch < 12) base = MVt + (size_t)(b * 4 + (ch - 8)) * 64 * ::TK;
            else if (ch < 40) { const int c8 = ch - 32; base = VdT + (size_t)(b * 4 + (c8 >> 1)) * 128 * ::TK; doff = 64 * (c8 & 1); }
            else base = VgT + (size_t)(b * 2 + (ch - 46)) * 64 * ::TK;
            const int tc0 = (is_ctx ? 0 : ::CTX) + tbase;
#pragma unroll
            for (int ai = 0; ai < 2; ++ai)
#pragma unroll
                for (int m = 0; m < 4; ++m) { const int tc = tc0 + ai * HALF + m * 16;
#pragma unroll
                    for (int bj = 0; bj < 2; ++bj)
#pragma unroll
                        for (int n = 0; n < 2; ++n) { const f32x4 v = acc[ai][bj][m][n];
#pragma unroll
                            for (int e = 0; e < 4; ++e) base[(size_t)(doff + 32 * bj + 16 * n + 4 * fq + e) * ::TK + tc] = ::f2bf(v[e]); }
                    __builtin_amdgcn_sched_barrier(0); }
            return;
        }
        const bool is_q = (ch < 24) || (ch >= 40 && ch < 44);
        const bool do_norm = ch >= 40;
        bf16_t* base; int toff = 0;
        if (ch < 24) { const int c8 = ch - 16; if (is_ctx) { base = Qdc + (size_t)(b * 8 + c8) * ::CTX * 64; } else { base = Qd + (size_t)(b * 8 + c8) * ::SEQ * 64; } }
        else if (ch < 32) { const int c8 = ch - 24; base = Kd + (size_t)(b * 8 + c8) * ::TK * 64; toff = is_ctx ? 0 : ::CTX; }
        else if (ch < 44) { const int hq = ch - 40; if (is_ctx) { base = Qgc + (size_t)(b * 4 + hq) * ::CTX * 64; } else { base = Qg + (size_t)(b * 4 + hq) * ::SEQ * 64; } }
        else { const int kvh = ch - 44; base = Kg + (size_t)(b * 2 + kvh) * ::TK * 64; toff = is_ctx ? 0 : ::CTX; }
        float invf[4];
#pragma unroll
        for (int e = 0; e < 4; ++e) invf[e] = ::fast_exp2(-(float)(4 * fq + e) * (13.287712379549449f / 16.0f));
        const float* gn = ((ch < 44) ? qn_g : kn_g) + 4 * fq;
        const float osc = is_q ? ::QSC : 1.0f;
#pragma unroll
        for (int ai = 0; ai < 2; ++ai)
#pragma unroll
            for (int m = 0; m < 4; ++m) {
                const int t = tbase + ai * HALF + m * 16;
                float r = osc;
                if (do_norm) {
                    float ss = 0.f;
#pragma unroll
                    for (int bj = 0; bj < 2; ++bj)
#pragma unroll
                        for (int n = 0; n < 2; ++n)
#pragma unroll
                            for (int e = 0; e < 4; ++e) ss += acc[ai][bj][m][n][e] * acc[ai][bj][m][n][e];
                    ss += __shfl_xor(ss, 16); ss += __shfl_xor(ss, 32);
                    r *= __builtin_amdgcn_rsqf(ss * (1.0f / 64.0f) + ::LN_EPS);
                }
                bf16_t* rp = base + (size_t)(toff + t) * 64 + 4 * fq;
#pragma unroll
                for (int bj = 0; bj < 2; ++bj) {
                    f32x4 lo = acc[ai][bj][m][0] * r, hi2 = acc[ai][bj][m][1] * r;
                    if (do_norm) { lo = lo * *(const f32x4*)(gn + 32 * bj); hi2 = hi2 * *(const f32x4*)(gn + 32 * bj + 16); }
                    if (!is_ctx) {
                        const float pos = bj == 0 ? (float)(t >> 6) : (float)(t & 63);
#pragma unroll
                        for (int e = 0; e < 4; ++e) { const float th = pos * invf[e]; const float cs = __cosf(th), sn = __sinf(th);
                            const float a = lo[e], bq = hi2[e]; lo[e] = a * cs - bq * sn; hi2[e] = bq * cs + a * sn; }
                    }
                    u32x2 w; w.x = ::pk2(lo[0], lo[1]); w.y = ::pk2(lo[2], lo[3]); *(u32x2*)(rp + 32 * bj) = w;
                    w.x = ::pk2(hi2[0], hi2[1]); w.y = ::pk2(hi2[2], hi2[3]); *(u32x2*)(rp + 32 * bj + 16) = w;
                    __builtin_amdgcn_sched_barrier(0);
                }
            }
    }
};

struct SingleOrder {
    int pm, pn; unsigned* cnt;
    __device__ bool next(int i, Unit& u) const { if (i > 0) return false; u.pm = pm; u.pn = pn; return true; }
    __device__ __forceinline__ void a_ready(const Unit&) const {}
    __device__ __forceinline__ void done(const Unit&) const { __builtin_amdgcn_fence(__ATOMIC_RELEASE, "agent"); if ((threadIdx.x & 63) == 0) __hip_atomic_fetch_add(cnt, 1u, __ATOMIC_RELAXED, __HIP_MEMORY_SCOPE_AGENT); }
};
template <class Epi, class Sched, bool ALIGN_EPI = false, bool SP2 = false>
__device__ __forceinline__ void gemm_phase(PG8_LAS unsigned char* lds, const Gemm g, const Sched& S, const Epi& E) {
    int tid_ = threadIdx.x; asm volatile("" : "+v"(tid_));
    const int tid = tid_, wid = __builtin_amdgcn_readfirstlane(tid >> 6), lane = tid & 63, wr = wid >> 2, wc = wid & 3, fr = lane & 15, fq = lane >> 4;
    const int K = g.K, nt = K / BK;
    unsigned voffA[2], voffB[2];
#pragma unroll
    for (int i = 0; i < 2; ++i) { int R, C; stage_rc(tid * 16 + i * 8192, R, C); const int Rb = Epi::PERM ? ((R & ~31) + perm32(R & 31)) : R;
        voffA[i] = (unsigned)(R * K + C) * 2u; voffB[i] = (unsigned)(Rb * K + C) * 2u; }
    const size_t kstep = (size_t)(BK * 2);
    const size_t hstep = (size_t)HALF * K * 2;
    const size_t tstep = 2 * hstep;
    const unsigned ldsw = (unsigned)wid * 1024u;
    const int aoff = lds_byte(wr * 64 + fr, fq * 8), boff = lds_byte(wc * 32 + fr, fq * 8);
#define PG8_SA(b, h) (((b) * 2 + (h)) * HTB)
#define PG8_SB(b, h) ((4 + (b) * 2 + (h)) * HTB)
#define PG8_STAGE(bufoff, gbase, voff) do { _Pragma("unroll") for (int _i = 0; _i < 2; ++_i) \
        __builtin_amdgcn_global_load_lds((const unsigned*)((const char*)(gbase) + (voff)[_i]), (PG8_LAS unsigned*)(lds + (bufoff) + ldsw + _i * 8192), 16, 0, 0); } while (0)
#define PG8_LDA(dst, b, h) do { _Pragma("unroll") for (int m = 0; m < 4; ++m) _Pragma("unroll") for (int k = 0; k < 2; ++k) dst[m][k] = *(const PG8_LAS bf16x8*)(lds + PG8_SA(b, h) + aoff + m * 2048 + k * 1024); } while (0)
#define PG8_LDB(dst, b, h) do { _Pragma("unroll") for (int n = 0; n < 2; ++n) _Pragma("unroll") for (int k = 0; k < 2; ++k) dst[n][k] = *(const PG8_LAS bf16x8*)(lds + PG8_SB(b, h) + boff + n * 2048 + k * 1024); } while (0)
#define PG8_MMA(ai, bj, At, Bt) do { __builtin_amdgcn_s_setprio(1); _Pragma("unroll") for (int m = 0; m < 4; ++m) _Pragma("unroll") for (int n = 0; n < 2; ++n) _Pragma("unroll") for (int k = 0; k < 2; ++k) \
        acc[ai][bj][m][n] = __builtin_amdgcn_mfma_f32_16x16x32_bf16(Bt[n][k], At[m][k], acc[ai][bj][m][n], 0, 0, 0); __builtin_amdgcn_s_setprio(0); } while (0)
#define PG8_WAIT_V(n) asm volatile("s_waitcnt vmcnt(" #n ")" ::: "memory")
#define PG8_WAIT_L(n) asm volatile("s_waitcnt lgkmcnt(" #n ")" ::: "memory")
#define PG8_BAR __builtin_amdgcn_s_barrier()
#define PG8_SCHED __builtin_amdgcn_sched_barrier(0)
    Unit cur, nxt; int ui = 0;
    if (!S.next(0, cur)) return;
    f32x4 acc[2][2][4][2];
#pragma unroll
    for (int a = 0; a < 2; ++a)
#pragma unroll
        for (int b = 0; b < 2; ++b)
#pragma unroll
            for (int m = 0; m < 4; ++m)
#pragma unroll
                for (int n = 0; n < 2; ++n) acc[a][b][m][n] = (f32x4){0.f, 0.f, 0.f, 0.f};
    bf16x8 At[4][2], B0[2][2], B1[2][2];
    const char* cA = (const char*)g.A + (size_t)cur.pm * tstep; const char* cB = (const char*)g.Bt + (size_t)cur.pn * tstep;
    S.a_ready(cur);
    if constexpr (SP2) {
        PG8_STAGE(PG8_SB(0, 0), cB, voffB); PG8_STAGE(PG8_SB(0, 1), cB + hstep, voffB); PG8_STAGE(PG8_SA(0, 0), cA, voffA); PG8_STAGE(PG8_SA(0, 1), cA + hstep, voffA);
        if (wr == 1) PG8_BAR;
        PG8_WAIT_V(2); PG8_BAR;
        PG8_STAGE(PG8_SB(1, 0), cB + kstep, voffB); PG8_STAGE(PG8_SA(1, 0), cA + kstep, voffA); PG8_STAGE(PG8_SB(1, 1), cB + hstep + kstep, voffB);
        PG8_WAIT_V(6); PG8_BAR;
    } else {
        PG8_STAGE(PG8_SB(0, 0), cB, voffB); PG8_STAGE(PG8_SA(0, 0), cA, voffA); PG8_STAGE(PG8_SB(0, 1), cB + hstep, voffB); PG8_STAGE(PG8_SA(0, 1), cA + hstep, voffA);
        if (wr == 1) PG8_BAR;
        PG8_WAIT_V(4); PG8_BAR;
        PG8_STAGE(PG8_SB(1, 0), cB + kstep, voffB); PG8_STAGE(PG8_SA(1, 0), cA + kstep, voffA); PG8_STAGE(PG8_SB(1, 1), cB + hstep + kstep, voffB);
        PG8_WAIT_V(6); PG8_BAR;
    }
    for (;;) {
        const bool has_next = S.next(ui + 1, nxt);
        const char* nA = has_next ? (const char*)g.A + (size_t)nxt.pm * tstep : cA; const char* nB = has_next ? (const char*)g.Bt + (size_t)nxt.pn * tstep : cB;
        for (int t = 0; t < nt; t += 2) {
            const bool last = (t == nt - 2);
            const char* a1 = cA + (size_t)(t + 1) * kstep;
            const char* a2 = last ? nA : cA + (size_t)(t + 2) * kstep; const char* b2 = last ? nB : cB + (size_t)(t + 2) * kstep;
            const char* a3 = a2 + kstep; const char* b3 = b2 + kstep;
            if (last && has_next) S.a_ready(nxt);
            if constexpr (SP2) {
            PG8_LDB(B0, 0, 0); PG8_LDB(B1, 0, 1); PG8_SCHED; PG8_LDA(At, 0, 0); PG8_STAGE(PG8_SA(1, 1), a1 + hstep, voffA);
            PG8_WAIT_V(8); PG8_WAIT_L(0); PG8_BAR; PG8_MMA(0, 0, At, B0); PG8_MMA(0, 1, At, B1); PG8_BAR; PG8_SCHED;
            PG8_LDA(At, 0, 1); PG8_STAGE(PG8_SB(0, 0), b2, voffB); PG8_STAGE(PG8_SB(0, 1), b2 + hstep, voffB); PG8_STAGE(PG8_SA(0, 0), a2, voffA);
            PG8_WAIT_V(8); PG8_WAIT_L(0); PG8_BAR; PG8_MMA(1, 0, At, B0); PG8_MMA(1, 1, At, B1); PG8_BAR; PG8_SCHED;
            PG8_LDB(B0, 1, 0); PG8_LDB(B1, 1, 1); PG8_SCHED; PG8_LDA(At, 1, 0); PG8_STAGE(PG8_SA(0, 1), a2 + hstep, voffA);
            PG8_WAIT_V(8); PG8_WAIT_L(0); PG8_BAR; PG8_MMA(0, 0, At, B0); PG8_MMA(0, 1, At, B1); PG8_BAR; PG8_SCHED;
            PG8_LDA(At, 1, 1); PG8_STAGE(PG8_SB(1, 0), b3, voffB); PG8_STAGE(PG8_SB(1, 1), b3 + hstep, voffB); PG8_STAGE(PG8_SA(1, 0), a3, voffA);
            PG8_WAIT_V(8); PG8_WAIT_L(0); PG8_BAR; PG8_MMA(1, 0, At, B0); PG8_MMA(1, 1, At, B1); PG8_BAR; PG8_SCHED;
            } else {
            PG8_LDB(B0, 0, 0); PG8_SCHED; PG8_LDA(At, 0, 0); PG8_STAGE(PG8_SA(1, 1), a1 + hstep, voffA);
            PG8_WAIT_L(8); PG8_BAR; PG8_WAIT_L(0); PG8_MMA(0, 0, At, B0); PG8_BAR; PG8_SCHED;
            PG8_LDB(B1, 0, 1); PG8_STAGE(PG8_SB(0, 0), b2, voffB);
            PG8_BAR; PG8_WAIT_L(0); PG8_MMA(0, 1, At, B1); PG8_BAR;
            PG8_LDA(At, 0, 1); PG8_STAGE(PG8_SA(0, 0), a2, voffA);
            PG8_BAR; PG8_WAIT_L(0); PG8_MMA(1, 0, At, B0); PG8_BAR; PG8_SCHED;
            PG8_STAGE(PG8_SB(0, 1), b2 + hstep, voffB);
            PG8_WAIT_V(6); PG8_BAR; PG8_MMA(1, 1, At, B1); PG8_BAR;
            PG8_LDB(B0, 1, 0); PG8_SCHED; PG8_LDA(At, 1, 0); PG8_STAGE(PG8_SA(0, 1), a2 + hstep, voffA);
            PG8_WAIT_L(8); PG8_BAR; PG8_WAIT_L(0); PG8_MMA(0, 0, At, B0); PG8_BAR; PG8_SCHED;
            PG8_LDB(B1, 1, 1); PG8_STAGE(PG8_SB(1, 0), b3, voffB);
            PG8_BAR; PG8_WAIT_L(0); PG8_MMA(0, 1, At, B1); PG8_BAR;
            PG8_LDA(At, 1, 1); PG8_STAGE(PG8_SA(1, 0), a3, voffA);
            PG8_BAR; PG8_WAIT_L(0); PG8_MMA(1, 0, At, B0); PG8_BAR; PG8_SCHED;
            PG8_STAGE(PG8_SB(1, 1), b3 + hstep, voffB);
            PG8_WAIT_V(6); PG8_BAR; PG8_MMA(1, 1, At, B1); PG8_BAR;
            }
        }
        if constexpr (ALIGN_EPI) { if (wr == 0) PG8_BAR; }
        if constexpr (!Epi::AFTER_DRAIN) { E(acc, cur, wr, wc, fr, fq); S.done(cur); }
        if (!has_next) break;
#pragma unroll
        for (int a = 0; a < 2; ++a)
#pragma unroll
            for (int b = 0; b < 2; ++b)
#pragma unroll
                for (int m = 0; m < 4; ++m)
#pragma unroll
                    for (int n = 0; n < 2; ++n) acc[a][b][m][n] = (f32x4){0.f, 0.f, 0.f, 0.f};
        cur = nxt; cA = nA; cB = nB; ++ui;
        if constexpr (ALIGN_EPI) { if (wr == 1) PG8_BAR; }
    }
    PG8_WAIT_V(0);
    if constexpr (!ALIGN_EPI) { if (wr == 0) PG8_BAR; }
    PG8_BAR;
    if constexpr (Epi::AFTER_DRAIN) { E.fused(acc, cur, wr, wc, fr, fq, lds, wid, lane); S.done(cur); }
#undef PG8_SA
#undef PG8_SB
#undef PG8_STAGE
#undef PG8_LDA
#undef PG8_LDB
#undef PG8_MMA
#undef PG8_WAIT_V
#undef PG8_WAIT_L
#undef PG8_BAR
#undef PG8_SCHED
}
}
#define XB_TMO      128
#define XB_XCNT(j)  (256  + 64 * (j))
#define XB_XSUB(j)  (1280 + 64 * (j))
#define XB_XGEN(j)  (2304 + 64 * (j))
#define XB_TOP      3328
#define XB_TOPGEN   3392
#define XCD_BAR_WORDS 3456
#define XB_SPIN_CAP (1u << 18)

__device__ __forceinline__ unsigned xb_ld(unsigned* p)              { return __hip_atomic_load(p, __ATOMIC_RELAXED, __HIP_MEMORY_SCOPE_AGENT); }
__device__ __forceinline__ unsigned xb_add(unsigned* p, unsigned v) { return __hip_atomic_fetch_add(p, v, __ATOMIC_RELAXED, __HIP_MEMORY_SCOPE_AGENT); }
__device__ __forceinline__ unsigned xb_xcc_id() { return (unsigned)__builtin_amdgcn_s_getreg((3 << 11) | 20) & 0xFu; }
#define XB_SPIN(cond, bar) do { unsigned _sp = 0; while (cond) { __builtin_amdgcn_s_sleep(1); \
    if ((++_sp & 255u) == 0u) { if (xb_ld(&(bar)[XB_TMO])) break; if (_sp > XB_SPIN_CAP) { atomicAdd(&(bar)[XB_TMO], 1u); break; } } } } while (0)

struct XcdBarrier {
    unsigned* bar; unsigned x;
    volatile LAS unsigned* st;
};

__device__ __forceinline__ XcdBarrier xcd_barrier_post(unsigned* bar, volatile LAS unsigned* st) {
    XcdBarrier b; b.bar = bar; b.x = xb_xcc_id(); b.st = st;
    if (threadIdx.x == 0) (void)xb_add(&bar[XB_XCNT(b.x)], 1u);
    return b;
}
__device__ __forceinline__ void xcd_barrier_complete(unsigned* bar, unsigned x, unsigned& nloc, unsigned& nx) {
    const unsigned G = gridDim.x * gridDim.y * gridDim.z;
    unsigned sum, cnt, mine, sp = 0u;
    for (;;) {
        sum = 0u; cnt = 0u; mine = 0u;
#pragma unroll
        for (unsigned j = 0; j < 16; ++j) { const unsigned c = xb_ld(&bar[XB_XCNT(j)]); sum += c; cnt += (c > 0u) ? 1u : 0u; mine = (j == x) ? c : mine; }
        if (sum == G) break;
        __builtin_amdgcn_s_sleep(1);
        if ((++sp & 255u) == 0u) { if (xb_ld(&bar[XB_TMO])) break; if (sp > XB_SPIN_CAP) { atomicAdd(&bar[XB_TMO], 1u); break; } }
    }
    nloc = mine > 0u ? mine : 1u; nx = cnt > 0u ? cnt : 1u;
}

__device__ __forceinline__ void xcd_barrier(const XcdBarrier& b_in) {
    XcdBarrier b = b_in; { unsigned xx_ = (unsigned)__builtin_amdgcn_readfirstlane((int)b.x); asm volatile("" : "+s"(xx_)); b.x = xx_; }
    asm volatile("s_waitcnt vmcnt(0)" ::: "memory");
    __syncthreads();
    if (threadIdx.x == 0) {
        unsigned* bar = b.bar;
        __builtin_amdgcn_s_waitcnt(0);
        unsigned nloc = b.st[0], nx = b.st[1];
        if (nloc == 0u) { xcd_barrier_complete(bar, b.x, nloc, nx); b.st[0] = nloc; b.st[1] = nx; }
        const unsigned old = xb_add(&bar[XB_XSUB(b.x)], 1u);
        const unsigned gen = old / nloc;
        if (old + 1u == (gen + 1u) * nloc) {
            __builtin_amdgcn_fence(__ATOMIC_RELEASE, "agent");
            asm volatile("s_waitcnt vmcnt(0)" ::: "memory");
            const unsigned og = xb_add(&bar[XB_TOP], 1u);
            const unsigned tg = og / nx;
            if (og + 1u == (tg + 1u) * nx) xb_add(&bar[XB_TOPGEN], 1u);
            else XB_SPIN(xb_ld(&bar[XB_TOPGEN]) == tg, bar);
            __builtin_amdgcn_fence(__ATOMIC_ACQUIRE, "agent");
            xb_add(&bar[XB_XGEN(b.x)], 1u);
            asm volatile("s_waitcnt vmcnt(0)" ::: "memory");
        } else {
            XB_SPIN(xb_ld(&bar[XB_XGEN(b.x)]) == gen, bar);
            __builtin_amdgcn_fence(__ATOMIC_ACQUIRE, "agent");
            asm volatile("s_waitcnt vmcnt(0)" ::: "memory");
        }
    }
    __syncthreads();
}

__device__ __forceinline__ float wave_sum(float v) {
#pragma unroll
    for (int o = 1; o < 64; o <<= 1) v += __shfl_xor(v, o);
    return v;
}
__device__ __forceinline__ int win_col(int p) {
    const int pn = p >> 8, q = p & 255, bj = q >> 7, wc = (q >> 5) & 3, x = q & 31, n = (x >> 2) & 1, fq = x >> 3, e = x & 3;
    const int delta = 32 * bj + 16 * n + 4 * fq + e, ch = 4 * pn + wc;
    if (ch < 16) return ch * 64 + delta;
    if (ch < 48) return 1040 + (ch - 16) * 64 + delta;
    if (ch == 48 && delta < 16) return 1024 + delta;
    return -1;
}
__device__ __forceinline__ int wf1_col(int p) {
    const int pn = p >> 8, q = p & 255, bj = q >> 7, r = q & 127;
    return bj * DFF + 128 * pn + r;
}
struct WcItem { const float* W; bf16_t* Wt; int K, Nlog, k0, n0, mode; };
__device__ __forceinline__ WcItem wc_decode(const Params& p, int l, int which, int it) {
    constexpr int I0 = 16 * (NIN / 64), I1 = 16 * 16, I2 = 16 * (NF1 / 64);
    const int n0 = (which & 1) ? I0 : 0, n1 = (which & 2) ? I1 : 0, n2 = (which & 4) ? I2 : 0;
    WcItem w; int r = it, ntn;
    if (r < n0) { w.W = p.w_in + (size_t)l * DM * INCOLS; w.Wt = (bf16_t*)(p.ws + WS_WIN); w.K = DM; w.Nlog = INCOLS; ntn = NIN / 64; w.mode = 0; }
    else if ((r -= n0) < n1) { w.W = p.w_out + (size_t)l * DM * DM; w.Wt = (bf16_t*)(p.ws + ((l & 1) ? WS_WOUTB : WS_WOUT)); w.K = DM; w.Nlog = DM; ntn = 16; w.mode = 1; }
    else if ((r -= n1) < n2) { w.W = p.w_f1 + (size_t)l * DM * NF1; w.Wt = (l & 1) ? (bf16_t*)((unsigned char*)p.out + DO_WF1B) : (bf16_t*)(p.ws + WS_WF1); w.K = DM; w.Nlog = NF1; ntn = NF1 / 64; w.mode = 2; }
    else { r -= n2; w.W = p.w_f2 + (size_t)l * DFF * DM; w.Wt = (bf16_t*)(p.ws + ((l & 1) ? WS_WF2B : WS_WF2)); w.K = DFF; w.Nlog = DM; ntn = 16; w.mode = 1; }
    w.k0 = (r / ntn) * 64; w.n0 = (r % ntn) * 64;
    return w;
}
__device__ __forceinline__ void wc_load(const WcItem& w, int tid, float (&v)[8]) {
    const int nn = tid & 63, kk = tid >> 6, pcol = w.n0 + nn;
    const int col = w.mode == 0 ? win_col(pcol) : (w.mode == 2 ? wf1_col(pcol) : pcol);
    const float* src = w.W + (size_t)(w.k0 + kk) * w.Nlog + (col >= 0 ? col : 0);
#pragma unroll
    for (int i = 0; i < 8; ++i) { const float x = src[(size_t)(8 * i) * w.Nlog]; v[i] = col >= 0 ? x : 0.f; }
}
__device__ __forceinline__ void wconv_phase(const Params& p, int l, int which, LAS unsigned char* lds) {
    constexpr int I0 = 16 * (NIN / 64), I1 = 16 * 16, I2 = 16 * (NF1 / 64), I3 = (DFF / 64) * 16;
    const int tot = ((which & 1) ? I0 : 0) + ((which & 2) ? I1 : 0) + ((which & 4) ? I2 : 0) + ((which & 8) ? I3 : 0);
    int tid_ = threadIdx.x; asm volatile("" : "+v"(tid_));
    const int tid = tid_;
    LAS float* tl = (LAS float*)lds;
    int it = blockIdx.x;
    if (it >= tot) return;
    WcItem cur = wc_decode(p, l, which, it);
    float v[8]; wc_load(cur, tid, v);
    for (;;) {
        const int nxt = it + gridDim.x; const bool has = nxt < tot;
        WcItem nw = cur; float vn[8];
        if (has) { nw = wc_decode(p, l, which, nxt); wc_load(nw, tid, vn); }
        { const int nn = tid & 63, kk = tid >> 6;
#pragma unroll
          for (int i = 0; i < 8; ++i) tl[(kk + 8 * i) * 65 + nn] = v[i]; }
        __syncthreads();
        { const int n = tid >> 3, c = tid & 7; const LAS float* s = tl + (8 * c) * 65 + n;
          u32x4 o; o.x = pk2(s[0], s[65]); o.y = pk2(s[2 * 65], s[3 * 65]); o.z = pk2(s[4 * 65], s[5 * 65]); o.w = pk2(s[6 * 65], s[7 * 65]);
          *(u32x4*)(cur.Wt + (size_t)(cur.n0 + n) * cur.K + cur.k0 + 8 * c) = o; }
        __syncthreads();
        if (!has) break;
        it = nxt; cur = nw;
#pragma unroll
        for (int i = 0; i < 8; ++i) v[i] = vn[i];
    }
}
__device__ __forceinline__ void wconv_dyn(const Params& p, int l, int which, unsigned* ctr, LAS unsigned char* lds) {
    constexpr int I0 = 16 * (NIN / 64), I1 = 16 * 16, I2 = 16 * (NF1 / 64), I3 = (DFF / 64) * 16;
    const int tot = ((which & 1) ? I0 : 0) + ((which & 2) ? I1 : 0) + ((which & 4) ? I2 : 0) + ((which & 8) ? I3 : 0);
    int tid_ = threadIdx.x; asm volatile("" : "+v"(tid_));
    const int tid = tid_;
    LAS float* tl = (LAS float*)lds;
    LAS int* slot = (LAS int*)(lds + LDS_BYTES - 16);
    for (;;) {
        if (tid == 0) *slot = (int)atomicAdd(ctr, 1u);
        __syncthreads();
        const int it = *slot;
        __syncthreads();
        if (it >= tot) break;
        const WcItem cur = wc_decode(p, l, which, it);
        float v[8]; wc_load(cur, tid, v);
        { const int nn = tid & 63, kk = tid >> 6;
#pragma unroll
          for (int i = 0; i < 8; ++i) tl[(kk + 8 * i) * 65 + nn] = v[i]; }
        __syncthreads();
        { const int n = tid >> 3, c = tid & 7; const LAS float* s = tl + (8 * c) * 65 + n;
          u32x4 o; o.x = pk2(s[0], s[65]); o.y = pk2(s[2 * 65], s[3 * 65]); o.z = pk2(s[4 * 65], s[5 * 65]); o.w = pk2(s[6 * 65], s[7 * 65]);
          *(u32x4*)(cur.Wt + (size_t)(cur.n0 + n) * cur.K + cur.k0 + 8 * c) = o; }
        __syncthreads();
    }
}
__device__ __forceinline__ void mod_phase(const Params& p, LAS unsigned char* lds) {
    LAS float* sc = (LAS float*)lds;
    LAS float* red = (LAS float*)(lds + 9 * 1024 * 4);
    float* mod = (float*)(p.ws + WS_MOD);
    int tid_ = threadIdx.x; asm volatile("" : "+v"(tid_));
    const int tid = tid_;
    constexpr int NIT = DEPTH * (MODW / 64);
    if ((int)blockIdx.x < NIT) {
        for (int i = tid; i < 9 * 1024; i += 512) { const float v = i < 8192 ? p.c[i] : p.c_ctx[i - 8192]; sc[i] = v / (1.0f + expf(-v)); }
        __syncthreads();
        for (int it = blockIdx.x; it < NIT; it += gridDim.x) {
            const int l = it / (MODW / 64), cb = it % (MODW / 64), j = tid & 63, kg = tid >> 6;
            const float* w = p.w_ada + (size_t)l * DM * MODW + cb * 64 + j;
            float a[9];
#pragma unroll
            for (int r = 0; r < 9; ++r) a[r] = 0.f;
#pragma unroll 16
            for (int k = kg * 128; k < kg * 128 + 128; ++k) { const float wv = w[(size_t)k * MODW];
#pragma unroll
                for (int r = 0; r < 9; ++r) a[r] += sc[r * 1024 + k] * wv; }
#pragma unroll
            for (int r = 0; r < 9; ++r) red[(kg * 9 + r) * 64 + j] = a[r];
            __syncthreads();
            if (tid < 64) { const float bv = p.b_ada[l * MODW + cb * 64 + j];
                for (int r = 0; r < 9; ++r) { float s = 0.f;
#pragma unroll
                    for (int g = 0; g < 8; ++g) s += red[(g * 9 + r) * 64 + j];
                    mod[((size_t)l * 9 + r) * MODW + cb * 64 + j] = s + bv; } }
            __syncthreads();
        }
    }
    if (blockIdx.x == gridDim.x - 1 && tid < 64) {
        float* lam = mod + (size_t)DEPTH * 9 * MODW;
        for (int l = 0; l < DEPTH; ++l) { const float* lv = p.dlam + l * 256;
            const float s01 = wave_sum(lv[tid] * lv[64 + tid]), s23 = wave_sum(lv[128 + tid] * lv[192 + tid]);
            if (tid == 0) { const float li = 0.8f - 0.6f * expf(-0.3f * (float)l); lam[2 * l] = expf(s01) - expf(s23) + li; lam[2 * l + 1] = li; } }
    }
}
__device__ __forceinline__ void init_rows_phase(const Params& p) {
    int tid_ = threadIdx.x; asm volatile("" : "+v"(tid_));
    const int lane = tid_ & 63, gw = blockIdx.x * 8 + (tid_ >> 6), NGW = gridDim.x * 8;
    float* X = (float*)(p.ws + WS_X); bf16_t* U = (bf16_t*)((unsigned char*)p.out + DO_U); const float* mod = (const float*)(p.ws + WS_MOD);
    for (int row0 = gw; row0 < MTOT; row0 += 2 * NGW) {
        f32x4 v[2][4]; int rows[2]; bool ok[2];
#pragma unroll
        for (int r = 0; r < 2; ++r) { const int rr = row0 + r * NGW; ok[r] = rr < MTOT; rows[r] = ok[r] ? rr : row0;
            const float* src = rows[r] < MLAT ? p.x + (size_t)rows[r] * DM : p.ctx + (size_t)(rows[r] - MLAT) * DM;
#pragma unroll
            for (int j = 0; j < 4; ++j) v[r][j] = *(const f32x4*)(src + 4 * lane + 256 * j); }
#pragma unroll
        for (int r = 0; r < 2; ++r) { if (!ok[r]) continue;
            const int row = rows[r]; const int bi = row < MLAT ? row / SEQ : 8;
            const float* sh = mod + (size_t)bi * MODW, *scp = sh + 1024;
#pragma unroll
            for (int j = 0; j < 4; ++j) { const int col = 4 * lane + 256 * j;
                const f32x4 s = *(const f32x4*)(scp + col), h = *(const f32x4*)(sh + col); const f32x4 u = v[r][j] * (s + 1.0f) + h;
                u32x2 w; w.x = pk2(u[0], u[1]); w.y = pk2(u[2], u[3]); *(u32x2*)(U + (size_t)row * DM + col) = w; } }
    }
}
__device__ __forceinline__ void ln_rows(const Params& p, const bf16_t* __restrict__ O, const float* gmod, const float* lng, const float* lnb, const float* nmod  ,
                                        float* outp, int lane, int row_first, int row_step, int row_end, const float* xin_lat = nullptr, const float* xin_ctx = nullptr) {
    float* X = (float*)(p.ws + WS_X); bf16_t* U = (bf16_t*)((unsigned char*)p.out + DO_U);
    for (int row0 = row_first; row0 < row_end; row0 += 2 * row_step) {
        f32x4 xv[2][4]; u32x2 ow[2][4]; int rows[2]; bool ok[2];
#pragma unroll
        for (int r = 0; r < 2; ++r) { const int rr = row0 + r * row_step; ok[r] = rr < row_end; rows[r] = ok[r] ? rr : row0;
#pragma unroll
            for (int j = 0; j < 4; ++j) { const int col = 4 * lane + 256 * j; const float* xs = xin_lat ? (rows[r] < MLAT ? xin_lat + (size_t)rows[r] * DM : xin_ctx + (size_t)(rows[r] - MLAT) * DM) : X + (size_t)rows[r] * DM; xv[r][j] = *(const f32x4*)(xs + col); ow[r][j] = *(const u32x2*)(O + (size_t)rows[r] * DM + col); } }
#pragma unroll
        for (int r = 0; r < 2; ++r) {
            const int row = rows[r]; const int bi = row < MLAT ? row / SEQ : 8;
            const float* g = gmod + (size_t)bi * MODW;
            f32x4 v[4]; float s = 0.f;
#pragma unroll
            for (int j = 0; j < 4; ++j) { const int col = 4 * lane + 256 * j; const f32x4 gv = *(const f32x4*)(g + col); f32x4 ov; ov[0] = bflo(ow[r][j].x); ov[1] = bfhi(ow[r][j].x); ov[2] = bflo(ow[r][j].y); ov[3] = bfhi(ow[r][j].y);
                v[j] = xv[r][j] * ALPHA + gv * ov; s += (v[j][0] + v[j][1]) + (v[j][2] + v[j][3]); }
            const float mean = wave_sum(s) * (1.0f / DM); float s2 = 0.f;
#pragma unroll
            for (int j = 0; j < 4; ++j) { v[j] = v[j] - mean; s2 += (v[j][0] * v[j][0] + v[j][1] * v[j][1]) + (v[j][2] * v[j][2] + v[j][3] * v[j][3]); }
            const float rstd = 1.0f / sqrtf(wave_sum(s2) * (1.0f / DM) + LN_EPS);
            if (ok[r]) {
#pragma unroll
                for (int j = 0; j < 4; ++j) { const int col = 4 * lane + 256 * j; const f32x4 y = v[j] * rstd * *(const f32x4*)(lng + col) + *(const f32x4*)(lnb + col);
                    if (outp) { *(f32x4*)(outp + (size_t)row * DM + col) = y; }
                    else { *(f32x4*)(X + (size_t)row * DM + col) = y;
                        const float* nm = nmod + (size_t)bi * MODW; const f32x4 u = y * (*(const f32x4*)(nm + 1024 + col) + 1.0f) + *(const f32x4*)(nm + col);
                        u32x2 w; w.x = pk2(u[0], u[1]); w.y = pk2(u[2], u[3]); *(u32x2*)(U + (size_t)row * DM + col) = w; } }
            }
        }
    }
}

constexpr int AT_KB = 9216;
#define MFMA32(a, b, c) __builtin_amdgcn_mfma_f32_32x32x16_bf16((a), (b), (c), 0, 0, 0)
__device__ __forceinline__ bf16x8 lds_rd16(const LAS unsigned char* p) { return *(const LAS bf16x8*)p; }
__device__ __forceinline__ bf16x8 lds_rd16v(const LAS unsigned char* p) { return *(const volatile LAS bf16x8*)p; }

__device__ __forceinline__ float max3f(float a, float b, float c) { float r; asm("v_max3_f32 %0, %1, %2, %3" : "=v"(r) : "v"(a), "v"(b), "v"(c)); return r; }
__device__ __forceinline__ float max2f(float a, float b) { float r; asm("v_max_f32_e32 %0, %1, %2" : "=v"(r) : "v"(a), "v"(b)); return r; }
__device__ __forceinline__ float rowmax32(const f32x16& a, const f32x16& b) {
    float m0 = max3f(a[0], a[1], b[0]), m1 = max3f(a[2], a[3], b[1]); m0 = max3f(m0, b[2], b[3]);
#pragma unroll
    for (int r = 4; r < 16; r += 4) { m0 = max3f(m0, a[r], a[r + 1]); m1 = max3f(m1, a[r + 2], a[r + 3]); m0 = max3f(m0, b[r], b[r + 1]); m1 = max3f(m1, b[r + 2], b[r + 3]); }
    const float m = max2f(m0, m1);
    auto rr = __builtin_amdgcn_permlane32_swap(__float_as_uint(m), __float_as_uint(m), false, false);
    return max2f(__uint_as_float(rr[0]), __uint_as_float(rr[1]));
}
constexpr int AT_K0 = 0, AT_V0 = 2 * AT_KB, AT_VB = 128 * 144;
template <int DV> struct AttnState {
    bf16x8 qr[4]; u32x4 kreg, vreg0, vreg1; f32x16 sc0, sc1, sd0, sd1, negm; f32x16 o[DV / 32]; float lsum, mrun;
    const bf16_t* kg; const bf16_t* vg; int kl, vl, koff, voff;
};
template <int DV, bool FULL>
__device__ __forceinline__ void attn_iter(AttnState<DV>& S, int t, int nt, LAS unsigned char* lds) {
    constexpr int NDB = DV / 32;
    const LAS unsigned char* BK = lds + AT_K0 + ((t + 1) & 1) * AT_KB;
    const LAS unsigned char* BV = lds + AT_V0 + (t & 1) * AT_VB;
    if (FULL || t + 2 < nt) *(LAS u32x4*)(lds + AT_K0 + (t & 1) * AT_KB + S.kl) = S.kreg;
    if (FULL || t + 1 < nt) { LAS unsigned char* W = lds + AT_V0 + ((t + 1) & 1) * AT_VB + S.vl; *(LAS u32x4*)W = S.vreg0; if (DV == 128) *(LAS u32x4*)(W + 64 * 144) = S.vreg1; }
    if (FULL || t + 3 < nt) S.kreg = *(const u32x4*)(S.kg + (size_t)(t + 3) * 4096);
    if (FULL || t + 2 < nt) { S.vreg0 = *(const u32x4*)(S.vg + (t + 2) * 64); if (DV == 128) S.vreg1 = *(const u32x4*)(S.vg + (size_t)64 * TK + (t + 2) * 64); }
    f32x16 sn0 = S.negm, sn1 = S.negm;
    if (FULL || t + 1 < nt) {
#pragma unroll
        for (int c = 0; c < 4; ++c) { const bf16x8 kf0 = lds_rd16(BK + S.koff + c * 32), kf1 = lds_rd16(BK + S.koff + 32 * 144 + c * 32);
            sn0 = MFMA32(kf0, S.qr[c], sn0); sn1 = MFMA32(kf1, S.qr[c], sn1); }
    }
    f32x16 p0, p1;
#pragma unroll
    for (int i = 0; i < 16; ++i) { p0[i] = fast_exp2(S.sc0[i]); p1[i] = fast_exp2(S.sc1[i]); }
    { const f32x16 s = p0 + p1; const f32x4 a = (f32x4){s[0], s[1], s[2], s[3]} + (f32x4){s[4], s[5], s[6], s[7]} + (f32x4){s[8], s[9], s[10], s[11]} + (f32x4){s[12], s[13], s[14], s[15]};
      S.lsum += (a[0] + a[1]) + (a[2] + a[3]); }
#pragma unroll
    for (int blk = 0; blk < 2; ++blk)
#pragma unroll
        for (int a = 0; a < 2; ++a) {
            u32x4 pw;
            if (blk == 0) { pw.x = pk2(p0[8 * a], p0[8 * a + 1]); pw.y = pk2(p0[8 * a + 2], p0[8 * a + 3]); pw.z = pk2(p0[8 * a + 4], p0[8 * a + 5]); pw.w = pk2(p0[8 * a + 6], p0[8 * a + 7]); }
            else { pw.x = pk2(p1[8 * a], p1[8 * a + 1]); pw.y = pk2(p1[8 * a + 2], p1[8 * a + 3]); pw.z = pk2(p1[8 * a + 4], p1[8 * a + 5]); pw.w = pk2(p1[8 * a + 6], p1[8 * a + 7]); }
            const bf16x8 pp = __builtin_bit_cast(bf16x8, pw);
#pragma unroll
            for (int d = 0; d < NDB; ++d) { const bf16x8 vf = lds_rd16(BV + S.voff + d * 32 * 144 + (32 * blk + 16 * a) * 2); S.o[d] = MFMA32(vf, pp, S.o[d]); }
        }
    float mx = 0.f;
    if (FULL || t + 1 < nt) mx = rowmax32(sn0, sn1);
    if (FULL || t + 1 < nt) {
        if (__any(mx > 8.0f)) {
            const float dl = fmaxf(mx, 0.f), alpha = fast_exp2(-dl);
            S.mrun += dl; S.lsum *= alpha;
#pragma unroll
            for (int i = 0; i < 16; ++i) { sn0[i] -= dl; sn1[i] -= dl; S.negm[i] = -S.mrun; }
#pragma unroll
            for (int d = 0; d < NDB; ++d)
#pragma unroll
                for (int i = 0; i < 16; ++i) S.o[d][i] *= alpha;
        }
    }
    S.sc0 = sn0; S.sc1 = sn1;
    __syncthreads();
}
template <int DV, int PAR, bool KW = true, bool KL = true, bool VL = true>
__device__ __forceinline__ void attn_iter_full(AttnState<DV>& S, int t, LAS unsigned char* lds) {
    constexpr int NDB = DV / 32, NS = 8 + 4 * NDB, NU = 27;
    const LAS unsigned char* BK = lds + AT_K0 + (PAR ^ 1) * AT_KB + S.koff;
    const LAS unsigned char* BV = lds + AT_V0 + PAR * AT_VB + S.voff;
    f32x16& C0 = PAR ? S.sd0 : S.sc0; f32x16& C1 = PAR ? S.sd1 : S.sc1; f32x16& sn0 = PAR ? S.sc0 : S.sd0; f32x16& sn1 = PAR ? S.sc1 : S.sd1;
    sn0 = S.negm; sn1 = S.negm;
    u32x4 pw[4]; float mxa = 0.f, mxb = 0.f, mx = 0.f; f32x16 ssum;
    constexpr int PD = (DV == 64) ? 3 : 2; bf16x8 fr[PD + 1];
#define AT_FRAG(i) (((i) < 8) ? lds_rd16v(BK + ((i) & 1) * 32 * 144 + ((i) >> 1) * 32) \
                              : lds_rd16v(BV + (((i) - 8) % NDB) * 32 * 144 + (32 * ((((i) - 8) / NDB) >> 1) + 16 * ((((i) - 8) / NDB) & 1)) * 2))
#pragma unroll
    for (int i = 0; i < PD; ++i) fr[i] = AT_FRAG(i);
    __builtin_amdgcn_sched_barrier(0);
#pragma unroll
    for (int i = 0; i < NS; ++i) {
        if (i + PD < NS) fr[(i + PD) % (PD + 1)] = AT_FRAG(i + PD);
        if (i == 3) {
            if (KW) *(LAS u32x4*)(lds + AT_K0 + PAR * AT_KB + S.kl) = S.kreg;
            LAS unsigned char* W = lds + AT_V0 + (PAR ^ 1) * AT_VB + S.vl; *(LAS u32x4*)W = S.vreg0; if (DV == 128) *(LAS u32x4*)(W + 64 * 144) = S.vreg1; }
        if (i == 5) { if (KL) S.kreg = *(const u32x4*)(S.kg + (size_t)(t + 3) * 4096);
            if (VL) { S.vreg0 = *(const u32x4*)(S.vg + (t + 2) * 64); if (DV == 128) S.vreg1 = *(const u32x4*)(S.vg + (size_t)64 * TK + (t + 2) * 64); } }
        if (i < 8) { if (i & 1) sn1 = MFMA32(fr[i % (PD + 1)], S.qr[i >> 1], sn1); else sn0 = MFMA32(fr[i % (PD + 1)], S.qr[i >> 1], sn0); }
        else { const int j = i - 8; S.o[j % NDB] = MFMA32(fr[i % (PD + 1)], __builtin_bit_cast(bf16x8, pw[j / NDB]), S.o[j % NDB]); }
#pragma unroll
        for (int u = 0; u < NU; ++u) {
            if (u * NS / NU != i) continue;
            if (u < 20) {
                const int q = u / 5, r = u % 5;
                if (r < 4) { const int e = 8 * q + 2 * r;
                    if (e < 16) { C0[e] = fast_exp2(C0[e]); C0[e + 1] = fast_exp2(C0[e + 1]); }
                    else { C1[e - 16] = fast_exp2(C1[e - 16]); C1[e - 15] = fast_exp2(C1[e - 15]); } }
                else { if (q < 2) { const int b0 = 8 * q; pw[q].x = pk2(C0[b0], C0[b0 + 1]); pw[q].y = pk2(C0[b0 + 2], C0[b0 + 3]); pw[q].z = pk2(C0[b0 + 4], C0[b0 + 5]); pw[q].w = pk2(C0[b0 + 6], C0[b0 + 7]); }
                       else { const int b0 = 8 * (q - 2); pw[q].x = pk2(C1[b0], C1[b0 + 1]); pw[q].y = pk2(C1[b0 + 2], C1[b0 + 3]); pw[q].z = pk2(C1[b0 + 4], C1[b0 + 5]); pw[q].w = pk2(C1[b0 + 6], C1[b0 + 7]); } }
            } else if (u == 20) { ssum = C0 + C1; }
            else if (u == 21) { const f32x4 a = (f32x4){ssum[0], ssum[1], ssum[2], ssum[3]} + (f32x4){ssum[4], ssum[5], ssum[6], ssum[7]} + (f32x4){ssum[8], ssum[9], ssum[10], ssum[11]} + (f32x4){ssum[12], ssum[13], ssum[14], ssum[15]};
                S.lsum += (a[0] + a[1]) + (a[2] + a[3]); }
            else if (u == 22) { mxa = max3f(sn0[0], sn0[1], sn1[0]); mxb = max3f(sn0[2], sn0[3], sn1[1]); mxa = max3f(mxa, sn1[2], sn1[3]); }
            else if (u < 26) { const int r = 4 * (u - 22); mxa = max3f(mxa, sn0[r], sn0[r + 1]); mxb = max3f(mxb, sn0[r + 2], sn0[r + 3]); mxa = max3f(mxa, sn1[r], sn1[r + 1]); mxb = max3f(mxb, sn1[r + 2], sn1[r + 3]); }
            else { const float m = max2f(mxa, mxb); auto rr = __builtin_amdgcn_permlane32_swap(__float_as_uint(m), __float_as_uint(m), false, false); mx = max2f(__uint_as_float(rr[0]), __uint_as_float(rr[1])); }
        }
        __builtin_amdgcn_sched_barrier(0);
    }
#undef AT_FRAG
    if (__any(mx > 8.0f)) {
        const float dl = fmaxf(mx, 0.f), alpha = fast_exp2(-dl);
        S.mrun += dl; S.lsum *= alpha;
#pragma unroll
        for (int i = 0; i < 16; ++i) { sn0[i] -= dl; sn1[i] -= dl; S.negm[i] = -S.mrun; }
#pragma unroll
        for (int d = 0; d < NDB; ++d)
#pragma unroll
            for (int i = 0; i < 16; ++i) S.o[d][i] *= alpha;
    }
    __syncthreads();
}
template <int DV>
__device__ __forceinline__ void attn_pass(const bf16_t* __restrict__ Qp, const bf16_t* __restrict__ Kp, const bf16_t* __restrict__ VTp, int nt,
                                          f32x16 (&o)[DV / 32], float& lout, LAS unsigned char* lds) {
    constexpr int NDB = DV / 32;
    int tid_ = threadIdx.x; asm volatile("" : "+v"(tid_));
    const int tid = tid_, lane = tid & 63, wid = tid >> 6, r32 = lane & 31, hi = lane >> 5;
    AttnState<DV> S;
    { const bf16_t* qrow = Qp + (size_t)(wid * 32 + r32) * 64 + hi * 8;
#pragma unroll
      for (int c = 0; c < 4; ++c) S.qr[c] = *(const bf16x8*)(qrow + c * 16); }
    const int lrow = tid >> 3, lseg = tid & 7;
    S.kg = Kp + (size_t)lrow * 64 + lseg * 8;
    S.vg = VTp + (size_t)lrow * TK + lseg * 8;
    S.kl = lrow * 144 + lseg * 16; S.vl = lrow * 144 + lseg * 16;
    const int kvr = (r32 & ~12) | (((r32 >> 2) & 1) << 3) | (((r32 >> 3) & 1) << 2);
    S.koff = kvr * 144 + hi * 16; S.voff = r32 * 144 + hi * 16;
    { const u32x4 k0 = *(const u32x4*)S.kg, k1 = *(const u32x4*)(S.kg + 4096), v0 = *(const u32x4*)S.vg;
      u32x4 v0b; if (DV == 128) v0b = *(const u32x4*)(S.vg + (size_t)64 * TK);
      *(LAS u32x4*)(lds + AT_K0 + S.kl) = k0; *(LAS u32x4*)(lds + AT_K0 + AT_KB + S.kl) = k1; *(LAS u32x4*)(lds + AT_V0 + S.vl) = v0; if (DV == 128) *(LAS u32x4*)(lds + AT_V0 + S.vl + 64 * 144) = v0b; }
    if (nt > 2) S.kreg = *(const u32x4*)(S.kg + (size_t)2 * 4096);
    S.vreg0 = *(const u32x4*)(S.vg + 64); if (DV == 128) S.vreg1 = *(const u32x4*)(S.vg + (size_t)64 * TK + 64);
    __syncthreads();
#pragma unroll
    for (int d = 0; d < NDB; ++d)
#pragma unroll
        for (int i = 0; i < 16; ++i) S.o[d][i] = 0.f;
    S.lsum = 0.f;
    {
        f32x16 s0, s1;
#pragma unroll
        for (int i = 0; i < 16; ++i) { s0[i] = 0.f; s1[i] = 0.f; }
#pragma unroll
        for (int c = 0; c < 4; ++c) { const bf16x8 kf0 = lds_rd16(lds + AT_K0 + S.koff + c * 32), kf1 = lds_rd16(lds + AT_K0 + S.koff + 32 * 144 + c * 32);
            s0 = MFMA32(kf0, S.qr[c], s0); s1 = MFMA32(kf1, S.qr[c], s1); }
        const float mx = rowmax32(s0, s1);
        S.mrun = mx;
#pragma unroll
        for (int i = 0; i < 16; ++i) { S.sc0[i] = s0[i] - mx; S.sc1[i] = s1[i] - mx; S.negm[i] = -mx; }
    }
    __syncthreads();
    int t = 0;
    for (; t + 4 < nt; t += 2) { attn_iter_full<DV, 0>(S, t, lds); attn_iter_full<DV, 1>(S, t + 1, lds); }
    if (nt - t == 4) {
        attn_iter_full<DV, 0, true, true, true>(S, t, lds); attn_iter_full<DV, 1, true, false, true>(S, t + 1, lds); attn_iter_full<DV, 0, false, false, false>(S, t + 2, lds); t += 3; S.sc0 = S.sd0; S.sc1 = S.sd1; }
    for (; t < nt; ++t) attn_iter<DV, false>(S, t, nt, lds);
#pragma unroll
    for (int d = 0; d < NDB; ++d) o[d] = S.o[d];
    lout = S.lsum + __shfl_xor(S.lsum, 32);
}

__device__ __forceinline__ void diff_unit(const Params& p, int l, int b, int h, int qb, bool ctxq, LAS unsigned char* lds) {
    int tid_ = threadIdx.x; asm volatile("" : "+v"(tid_));
    const int lane = tid_ & 63, wid = tid_ >> 6, r32 = lane & 31, hi = lane >> 5;
    const bf16_t* Q1; const bf16_t* Q2; int nt; size_t yrow;
    if (ctxq) { Q1 = (const bf16_t*)(p.ws + WS_QDC) + (size_t)(b * 8 + 2 * h) * CTX * 64; Q2 = Q1 + (size_t)CTX * 64; nt = CTX / 64; yrow = (size_t)MLAT + b * CTX + wid * 32 + r32; }
    else { Q1 = (const bf16_t*)(p.ws + WS_QD) + ((size_t)(b * 8 + 2 * h) * SEQ + qb * 256) * 64; Q2 = Q1 + (size_t)SEQ * 64; nt = TK / 64; yrow = (size_t)b * SEQ + qb * 256 + wid * 32 + r32; }
    const bf16_t* K1 = (const bf16_t*)(p.ws + WS_KD) + (size_t)(b * 8 + 2 * h) * TK * 64; const bf16_t* K2 = K1 + (size_t)TK * 64;
    const bf16_t* VT = (const bf16_t*)(p.ws + WS_VDT) + (size_t)(b * 4 + h) * 128 * TK;
    const float* lamp = (const float*)(p.ws + WS_MOD) + (size_t)DEPTH * 9 * MODW + 2 * l;
    const float lam = lamp[0], lam_init = lamp[1];
    f32x16 o1[4], o2[4]; float l1, l2;
    LAS unsigned* stash = (LAS unsigned*)(lds + AT_V0 + 2 * AT_VB) + tid_;
    attn_pass<128>(Q1, K1, VT, nt, o1, l1, lds);
    { const float i1 = 1.0f / l1;
#pragma unroll
      for (int d = 0; d < 4; ++d)
#pragma unroll
          for (int i = 0; i < 8; ++i) stash[(d * 8 + i) * 512] = pk2(o1[d][2 * i] * i1, o1[d][2 * i + 1] * i1); }
    attn_pass<128>(Q2, K2, VT, nt, o2, l2, lds);
    const float c2 = lam / l2; float ss = 0.f;
#pragma unroll
    for (int d = 0; d < 4; ++d)
#pragma unroll
        for (int i = 0; i < 8; ++i) { const unsigned w = stash[(d * 8 + i) * 512]; o1[d][2 * i] = bflo(w) - c2 * o2[d][2 * i]; o1[d][2 * i + 1] = bfhi(w) - c2 * o2[d][2 * i + 1]; ss += o1[d][2 * i] * o1[d][2 * i] + o1[d][2 * i + 1] * o1[d][2 * i + 1]; }
    ss += __shfl_xor(ss, 32);
    const float r = __builtin_amdgcn_rsqf(ss * (1.0f / 128.0f) + LN_EPS) * (1.0f - lam_init);
    const float* gn = p.dnorm_g + l * 128;
    bf16_t* yp = (bf16_t*)(p.ws + WS_Y) + yrow * DM + 256 + h * 128;
#pragma unroll
    for (int d = 0; d < 4; ++d)
#pragma unroll
        for (int ig = 0; ig < 4; ++ig) { const int dd = 32 * d + 8 * ig + 4 * hi; const f32x4 g4 = *(const f32x4*)(gn + dd);
            u32x2 w; w.x = pk2(o1[d][4 * ig] * r * g4[0], o1[d][4 * ig + 1] * r * g4[1]); w.y = pk2(o1[d][4 * ig + 2] * r * g4[2], o1[d][4 * ig + 3] * r * g4[3]);
            *(u32x2*)(yp + dd) = w; }
}
__device__ __forceinline__ void gqa_unit(const Params& p, int b, int hq, int qb, bool ctxq, LAS unsigned char* lds) {
    int tid_ = threadIdx.x; asm volatile("" : "+v"(tid_));
    const int lane = tid_ & 63, wid = tid_ >> 6, r32 = lane & 31, hi = lane >> 5;
    const bf16_t* Q; int nt; size_t yrow;
    if (ctxq) { Q = (const bf16_t*)(p.ws + WS_QGC) + (size_t)(b * 4 + hq) * CTX * 64; nt = CTX / 64; yrow = (size_t)MLAT + b * CTX + wid * 32 + r32; }
    else { Q = (const bf16_t*)(p.ws + WS_QG) + ((size_t)(b * 4 + hq) * SEQ + qb * 256) * 64; nt = TK / 64; yrow = (size_t)b * SEQ + qb * 256 + wid * 32 + r32; }
    const int kvh = hq >> 1;
    const bf16_t* K = (const bf16_t*)(p.ws + WS_KG) + (size_t)(b * 2 + kvh) * TK * 64;
    const bf16_t* VT = (const bf16_t*)(p.ws + WS_VGT) + (size_t)(b * 2 + kvh) * 64 * TK;
    f32x16 o[2]; float ls;
    attn_pass<64>(Q, K, VT, nt, o, ls, lds);
    const float il = 1.0f / ls;
    bf16_t* yp = (bf16_t*)(p.ws + WS_Y) + yrow * DM + 768 + hq * 64;
#pragma unroll
    for (int d = 0; d < 2; ++d)
#pragma unroll
        for (int ig = 0; ig < 4; ++ig) { const int dd = 32 * d + 8 * ig + 4 * hi;
            u32x2 w; w.x = pk2(o[d][4 * ig] * il, o[d][4 * ig + 1] * il); w.y = pk2(o[d][4 * ig + 2] * il, o[d][4 * ig + 3] * il);
            *(u32x2*)(yp + dd) = w; }
}

constexpr int ML_QS = 0, ML_KS = 9216, ML_KT = 18432, ML_VT = 27648, ML_SW = 36864, ML_CT0 = 46080, ML_CT1 = 55296, ML_TAB = 64512, ML_GSZ = 67072;
constexpr int T_A = 0, T_BIGA = 256, T_WP = 512, T_U = 768, T_EMT = 1024, T_DP0 = 1280, T_DP1 = 1536, T_DI = 1792, T_NV0 = 2048, T_NV1 = 2304;
constexpr size_t ML_UNIT_BYTES = (size_t)3 * TK * 64 * 2 + (size_t)2 * TK * 16;

__device__ __forceinline__ void mlstm_unit(const Params& p, int l, int b, int h, LAS unsigned char* lds) {
    int tid_ = threadIdx.x; asm volatile("" : "+v"(tid_));
    const int tid = tid_, lane = tid & 63, wave = __builtin_amdgcn_readfirstlane(tid >> 6), g = wave >> 2, w4 = wave & 3, tid4 = tid & 255, r32 = lane & 31, hi = lane >> 5;
    LAS unsigned char* L = lds + g * ML_GSZ;
    const bf16_t* Pm = (const bf16_t*)(p.ws + WS_PM);
    const bf16_t* MVt = (const bf16_t*)(p.ws + WS_MVT) + (size_t)(b * 4 + h) * 64 * TK;
    const float* G = (const float*)(p.ws + WS_GATES);
    unsigned char* ub = p.ws + WS_ML + (size_t)(b * 4 + h) * ML_UNIT_BYTES;
    bf16_t* QA = (bf16_t*)ub; bf16_t* KA = QA + (size_t)TK * 64; bf16_t* KAT = KA + (size_t)TK * 64; f32x4* SC = (f32x4*)(KAT + (size_t)TK * 64);
    bf16_t* HX = (bf16_t*)((unsigned char*)p.out + (g ? DO_HB : DO_HF));
    const int ctxrow0 = MLAT + b * CTX, latrow0 = b * SEQ;
    for (int i = tid4; i < ML_GSZ / 16; i += 256) *(LAS u32x4*)(L + i * 16) = (u32x4){0u, 0u, 0u, 0u};
    {
        float wq[5], wk[5], bq, bk;
        { const float* cw = p.conv_w + (size_t)l * 5 * 512; const float* cb = p.conv_b + l * 512;
#pragma unroll
          for (int j = 0; j < 5; ++j) { wq[j] = cw[j * 512 + h * 64 + lane]; wk[j] = cw[j * 512 + 256 + h * 64 + lane]; }
          bq = cb[h * 64 + lane]; bk = cb[256 + h * 64 + lane]; }
#define PP_LOAD(gi_, QR, KR, MSK) do { const int tau0_ = (gi_) * 8; const bool isc_ = tau0_ < CTX; const int lo_ = isc_ ? 0 : CTX, hi_ = isc_ ? CTX : TK; MSK = 0u; \
            _Pragma("unroll") for (int i_ = 0; i_ < 12; ++i_) { const int tau_ = tau0_ - 2 + i_; const bool ok_ = tau_ >= lo_ && tau_ < hi_; const int tc_ = ok_ ? tau_ : tau0_; \
                const size_t row_ = tc_ < CTX ? (size_t)(ctxrow0 + tc_) : (size_t)(latrow0 + tc_ - CTX); const bf16_t* src_ = Pm + row_ * 768 + h * 64 + lane; QR[i_] = src_[0]; KR[i_] = src_[256]; MSK |= ok_ ? (1u << i_) : 0u; } } while (0)
        unsigned short qa_[12], ka_[12], qb_[12], kb_[12]; unsigned ma_ = 0u, mb_ = 0u;
        PP_LOAD(wave, qa_, ka_, ma_);
        for (int gi = wave; gi < TK / 8; gi += 8) {
            const int tau0 = gi * 8;
            if (gi + 8 < TK / 8) PP_LOAD(gi + 8, qb_, kb_, mb_);
            float qf[12], kf[12];
#pragma unroll
            for (int i = 0; i < 12; ++i) { const bool ok = (ma_ >> i) & 1u; qf[i] = ok ? bf2f(qa_[i]) : 0.f; kf[i] = ok ? bf2f(ka_[i]) : 0.f; }
            float ko[8];
#pragma unroll
            for (int i = 0; i < 8; ++i) { float qv = bq, kv = bk;
#pragma unroll
                for (int jj = 0; jj < 5; ++jj) { qv += wq[jj] * qf[i + jj]; kv += wk[jj] * kf[i + jj]; }
                const float qo = silu_f(qv) * 0.125f; ko[i] = silu_f(kv);
                QA[(size_t)(tau0 + i) * 64 + lane] = f2bf(qo); KA[(size_t)(tau0 + i) * 64 + lane] = f2bf(ko[i]); }
            u32x4 kt; kt.x = pk2(ko[0], ko[1]); kt.y = pk2(ko[2], ko[3]); kt.z = pk2(ko[4], ko[5]); kt.w = pk2(ko[6], ko[7]);
            *(u32x4*)(KAT + (size_t)lane * TK + tau0) = kt;
#pragma unroll
            for (int i = 0; i < 12; ++i) { qa_[i] = qb_[i]; ka_[i] = kb_[i]; }
            ma_ = mb_;
        }
#undef PP_LOAD
    }
    {
        float ipn, fpn;
#define PB_LOAD(it_, IP, FP) do { const int dir_ = (it_) >= 68, c_ = dir_ ? (it_) - 68 : (it_); const int tk_ = dir_ ? 63 - lane : lane; const int tau_ = c_ * 64 + tk_; \
            const size_t row_ = tau_ < CTX ? (size_t)(ctxrow0 + tau_) : (size_t)(latrow0 + tau_ - CTX); const float* gs_ = G + row_ * 16 + (dir_ ? 4 : 0) + h; IP = gs_[0]; FP = gs_[8]; } while (0)
        float ipc, fpc; PB_LOAD(wave, ipc, fpc);
        for (int it = wave; it < 136; it += 8) {
            if (it + 8 < 136) PB_LOAD(it + 8, ipn, fpn);
            const int dir = it >= 68, c = dir ? it - 68 : it; const int tk = dir ? 63 - lane : lane; const int tau = c * 64 + tk;
            const float ipre = ipc, fpre = fpc;
            const float lf = fminf(fpre, 0.f) - log1pf(expf(-fabsf(fpre)));
            float bc = lf;
#pragma unroll
            for (int d = 1; d < 64; d <<= 1) { const float y = __shfl_up(bc, d); if (lane >= d) bc += y; }
            const float av = ipre - bc;
            float cm = av;
#pragma unroll
            for (int d = 1; d < 64; d <<= 1) { const float y = __shfl_up(cm, d); if (lane >= d) cm = fmaxf(cm, y); }
            SC[(size_t)dir * TK + tau] = (f32x4){bc, av, cm, 0.f};
            ipc = ipn; fpc = fpn;
        }
#undef PB_LOAD
    }
    asm volatile("s_waitcnt vmcnt(0)" ::: "memory"); __syncthreads();
    const int tok = g ? 63 - lane : lane;
    f32x16 Cacc;
#pragma unroll
    for (int i = 0; i < 16; ++i) Cacc[i] = 0.f;
    float nreg = 0.f, mstate = 0.f;
    u32x4 rq0, rq1, rk0, rk1, rt0, rt1, rv0, rv1; f32x4 rsc;
#define CHUNK_OF(j) (g ? ((j) < 4 ? 3 - (j) : 71 - (j)) : (j))
#define ML_PREFETCH(j) do { const int c_ = CHUNK_OF(j); const int rr_ = tid4 >> 2, cc_ = (tid4 & 3) * 16; \
        { const bf16_t* s_ = QA + (size_t)(c_ * 64 + rr_) * 64 + cc_; rq0 = *(const u32x4*)s_; rq1 = *(const u32x4*)(s_ + 8); } \
        { const bf16_t* s_ = KA + (size_t)(c_ * 64 + rr_) * 64 + cc_; rk0 = *(const u32x4*)s_; rk1 = *(const u32x4*)(s_ + 8); } \
        { const bf16_t* s_ = KAT + (size_t)rr_ * TK + c_ * 64 + cc_; rt0 = *(const u32x4*)s_; rt1 = *(const u32x4*)(s_ + 8); } \
        { const bf16_t* s_ = MVt + (size_t)rr_ * TK + c_ * 64 + cc_; rv0 = *(const u32x4*)s_; rv1 = *(const u32x4*)(s_ + 8); } \
        rsc = SC[(size_t)g * TK + c_ * 64 + tok]; } while (0)
#define ML_BAR() asm volatile("s_waitcnt lgkmcnt(0)\n\ts_barrier" ::: "memory")
    ML_PREFETCH(0);
    int cur = 0;
    for (int j = 0; j < 68; ++j) {
        const int cidx = CHUNK_OF(j);
        const float bc = rsc[0], av = rsc[1], cm = rsc[2];
        const float Aq = fmaxf(cm, mstate);
        const float wp = fast_exp(mstate - Aq), emt = fast_exp(-(bc + Aq));
        const float A63 = __shfl(Aq, 63), bl = __shfl(bc, 63);
        const float uu = fast_exp(av - A63), decay = fast_exp(mstate - A63), mnext = bl + A63;
        if (w4 == 0) { LAS float* tb = (LAS float*)(L + ML_TAB); tb[T_A / 4 + tok] = av; tb[T_BIGA / 4 + tok] = Aq; tb[T_WP / 4 + tok] = wp; tb[T_U / 4 + tok] = uu; tb[T_EMT / 4 + tok] = emt; }
        { const int o_ = (tid4 >> 2) * 144 + (tid4 & 3) * 32;
          *(LAS u32x4*)(L + ML_QS + o_) = rq0; *(LAS u32x4*)(L + ML_QS + o_ + 16) = rq1; *(LAS u32x4*)(L + ML_KS + o_) = rk0; *(LAS u32x4*)(L + ML_KS + o_ + 16) = rk1;
          *(LAS u32x4*)(L + ML_KT + o_) = rt0; *(LAS u32x4*)(L + ML_KT + o_ + 16) = rt1; *(LAS u32x4*)(L + ML_VT + o_) = rv0; *(LAS u32x4*)(L + ML_VT + o_ + 16) = rv1; }
        if (j + 1 < 68) ML_PREFETCH(j + 1);
        ML_BAR();
        const LAS unsigned char* CTc = L + (cur ? ML_CT1 : ML_CT0); LAS unsigned char* CTn = L + (cur ? ML_CT0 : ML_CT1);
        const LAS float* tb = (const LAS float*)(L + ML_TAB);
        {
            const int sblk = w4 & 1, tblk = w4 >> 1;
            f32x16 st;
#pragma unroll
            for (int i = 0; i < 16; ++i) st[i] = 0.f;
#pragma unroll
            for (int c = 0; c < 4; ++c) { const bf16x8 af = lds_rd16(L + ML_KS + (32 * sblk + r32) * 144 + hi * 16 + c * 32), bfr = lds_rd16(L + ML_QS + (32 * tblk + r32) * 144 + hi * 16 + c * 32); st = MFMA32(af, bfr, st); }
            const int t = 32 * tblk + r32; const float At = tb[T_BIGA / 4 + t];
            float dsum = 0.f;
#pragma unroll
            for (int ig = 0; ig < 4; ++ig) { const int s0 = 32 * sblk + 8 * ig + 4 * hi; const f32x4 a4 = *(const LAS f32x4*)(L + ML_TAB + T_A + s0 * 4);
                float w[4];
#pragma unroll
                for (int e = 0; e < 4; ++e) { const int s = s0 + e; const bool valid = g ? (s >= t) : (s <= t); const float ex = fast_exp(fminf(a4[e] - At, 0.f)); w[e] = valid ? st[4 * ig + e] * ex : 0.f; dsum += w[e]; }
                u32x2 pw; pw.x = pk2(w[0], w[1]); pw.y = pk2(w[2], w[3]); *(LAS u32x2*)(L + ML_SW + t * 144 + s0 * 2) = pw; }
            dsum += __shfl_xor(dsum, 32);
            if (hi == 0) *(LAS float*)(L + ML_TAB + (sblk ? T_DP1 : T_DP0) + t * 4) = dsum;
        }
        {
            const int dblk = w4 & 1, vblk = w4 >> 1;
#pragma unroll
            for (int i = 0; i < 16; ++i) Cacc[i] *= decay;
#pragma unroll
            for (int c = 0; c < 4; ++c) { const bf16x8 af = lds_rd16(L + ML_KT + (32 * dblk + r32) * 144 + hi * 16 + c * 32);
                const u32x4 vv = *(const LAS u32x4*)(L + ML_VT + (32 * vblk + r32) * 144 + hi * 16 + c * 32);
                const f32x4 u0 = *(const LAS f32x4*)(L + ML_TAB + T_U + (16 * c + 8 * hi) * 4), u1 = *(const LAS f32x4*)(L + ML_TAB + T_U + (16 * c + 8 * hi + 4) * 4);
                u32x4 sv; sv.x = pk2(bflo(vv.x) * u0[0], bfhi(vv.x) * u0[1]); sv.y = pk2(bflo(vv.y) * u0[2], bfhi(vv.y) * u0[3]); sv.z = pk2(bflo(vv.z) * u1[0], bfhi(vv.z) * u1[1]); sv.w = pk2(bflo(vv.w) * u1[2], bfhi(vv.w) * u1[3]);
                Cacc = MFMA32(af, __builtin_bit_cast(bf16x8, sv), Cacc); }
#pragma unroll
            for (int ig = 0; ig < 4; ++ig) { const int d0 = 32 * dblk + 8 * ig + 4 * hi; u32x2 pw; pw.x = pk2(Cacc[4 * ig], Cacc[4 * ig + 1]); pw.y = pk2(Cacc[4 * ig + 2], Cacc[4 * ig + 3]);
                *(LAS u32x2*)(CTn + (32 * vblk + r32) * 144 + d0 * 2) = pw; }
        }
        if (w4 == 0) {
            float s = 0.f;
#pragma unroll
            for (int c = 0; c < 8; ++c) { const u32x4 v = *(const LAS u32x4*)(L + ML_KT + lane * 144 + c * 16); const f32x4 u0 = *(const LAS f32x4*)(L + ML_TAB + T_U + c * 32), u1 = *(const LAS f32x4*)(L + ML_TAB + T_U + c * 32 + 16);
                s += bflo(v.x) * u0[0] + bfhi(v.x) * u0[1] + bflo(v.y) * u0[2] + bfhi(v.y) * u0[3] + bflo(v.z) * u1[0] + bfhi(v.z) * u1[1] + bflo(v.w) * u1[2] + bfhi(v.w) * u1[3]; }
            nreg = decay * nreg + s;
            *(LAS float*)(L + ML_TAB + (cur ? T_NV0 : T_NV1) + lane * 4) = nreg;
        } else if (w4 == 1) {
            const LAS unsigned char* nv = L + ML_TAB + (cur ? T_NV1 : T_NV0); float s = 0.f;
#pragma unroll
            for (int c = 0; c < 8; ++c) { const u32x4 v = *(const LAS u32x4*)(L + ML_QS + lane * 144 + c * 16); const f32x4 n0 = *(const LAS f32x4*)(nv + c * 32), n1 = *(const LAS f32x4*)(nv + c * 32 + 16);
                s += bflo(v.x) * n0[0] + bfhi(v.x) * n0[1] + bflo(v.y) * n0[2] + bfhi(v.y) * n0[3] + bflo(v.z) * n1[0] + bfhi(v.z) * n1[1] + bflo(v.w) * n1[2] + bfhi(v.w) * n1[3]; }
            *(LAS float*)(L + ML_TAB + T_DI + lane * 4) = s;
        }
        ML_BAR();
        {
            const int tblk = w4 & 1, vblk = w4 >> 1;
            f32x16 a1, a2;
#pragma unroll
            for (int i = 0; i < 16; ++i) { a1[i] = 0.f; a2[i] = 0.f; }
#pragma unroll
            for (int c = 0; c < 4; ++c) { const bf16x8 bv = lds_rd16(L + ML_VT + (32 * vblk + r32) * 144 + hi * 16 + c * 32), as = lds_rd16(L + ML_SW + (32 * tblk + r32) * 144 + hi * 16 + c * 32);
                const bf16x8 aq = lds_rd16(L + ML_QS + (32 * tblk + r32) * 144 + hi * 16 + c * 32), bc2 = lds_rd16(CTc + (32 * vblk + r32) * 144 + hi * 16 + c * 32);
                a1 = MFMA32(as, bv, a1); a2 = MFMA32(aq, bc2, a2); }
            const int tau0 = cidx * 64; const size_t rowc = tau0 < CTX ? (size_t)(ctxrow0 + tau0) : (size_t)(latrow0 + tau0 - CTX);
            bf16_t* hp = HX + rowc * 256 + h * 64 + 32 * vblk + r32;
#pragma unroll
            for (int ig = 0; ig < 4; ++ig) { const int t0 = 32 * tblk + 8 * ig + 4 * hi;
                const f32x4 d0 = *(const LAS f32x4*)(L + ML_TAB + T_DP0 + t0 * 4), d1 = *(const LAS f32x4*)(L + ML_TAB + T_DP1 + t0 * 4), di = *(const LAS f32x4*)(L + ML_TAB + T_DI + t0 * 4),
                            w4v = *(const LAS f32x4*)(L + ML_TAB + T_WP + t0 * 4), em = *(const LAS f32x4*)(L + ML_TAB + T_EMT + t0 * 4);
#pragma unroll
                for (int e = 0; e < 4; ++e) { const float den = d0[e] + d1[e] + w4v[e] * di[e]; const float dn = fmaxf(fabsf(den), em[e]);
                    const float hv = (a1[4 * ig + e] + w4v[e] * a2[4 * ig + e]) * fast_rcp(dn); hp[(size_t)(t0 + e) * 256] = f2bf(hv); } }
        }
        mstate = mnext; cur ^= 1;
        ML_BAR();
    }
#undef ML_PREFETCH
#undef ML_BAR
#undef CHUNK_OF
    asm volatile("s_waitcnt vmcnt(0)" ::: "memory"); __syncthreads();
    {
        const bf16_t* HF = (const bf16_t*)((unsigned char*)p.out + DO_HF); const bf16_t* HB = (const bf16_t*)((unsigned char*)p.out + DO_HB);
        bf16_t* Y = (bf16_t*)(p.ws + WS_Y);
        const int seg = tid & 3; const float* gp = p.mnorm_g + l * 256 + h * 64 + seg * 16;
        float gg[16];
#pragma unroll
        for (int i = 0; i < 16; ++i) gg[i] = gp[i];
        for (int it = 0; it < TK / 128; it += 2) {
            size_t rows[2]; u32x4 fa[2], fb[2], ba[2], bb[2], oa[2], ob[2];
#pragma unroll
            for (int r = 0; r < 2; ++r) { const int idx = (it + r) * 128 + (tid >> 2); rows[r] = idx < SEQ ? (size_t)b * SEQ + idx : (size_t)MLAT + b * CTX + (idx - SEQ);
                const size_t row = rows[r];
                fa[r] = *(const u32x4*)(HF + row * 256 + h * 64 + seg * 16); fb[r] = *(const u32x4*)(HF + row * 256 + h * 64 + seg * 16 + 8);
                ba[r] = *(const u32x4*)(HB + row * 256 + h * 64 + seg * 16); bb[r] = *(const u32x4*)(HB + row * 256 + h * 64 + seg * 16 + 8);
                oa[r] = *(const u32x4*)(Pm + row * 768 + 512 + h * 64 + seg * 16); ob[r] = *(const u32x4*)(Pm + row * 768 + 512 + h * 64 + seg * 16 + 8); }
#pragma unroll
            for (int r = 0; r < 2; ++r) {
                float v[16], og[16];
                const unsigned fw[8] = {fa[r].x, fa[r].y, fa[r].z, fa[r].w, fb[r].x, fb[r].y, fb[r].z, fb[r].w}, bw[8] = {ba[r].x, ba[r].y, ba[r].z, ba[r].w, bb[r].x, bb[r].y, bb[r].z, bb[r].w},
                               ow[8] = {oa[r].x, oa[r].y, oa[r].z, oa[r].w, ob[r].x, ob[r].y, ob[r].z, ob[r].w};
                float sm = 0.f;
#pragma unroll
                for (int i = 0; i < 8; ++i) { v[2 * i] = bflo(fw[i]) + bflo(bw[i]); v[2 * i + 1] = bfhi(fw[i]) + bfhi(bw[i]); og[2 * i] = bflo(ow[i]); og[2 * i + 1] = bfhi(ow[i]); sm += v[2 * i] + v[2 * i + 1]; }
                sm += __shfl_xor(sm, 1); sm += __shfl_xor(sm, 2);
                const float mu = sm * (1.0f / 64.0f); float s2 = 0.f;
#pragma unroll
                for (int i = 0; i < 16; ++i) { v[i] -= mu; s2 += v[i] * v[i]; }
                s2 += __shfl_xor(s2, 1); s2 += __shfl_xor(s2, 2);
                const float rstd = 1.0f / sqrtf(s2 * (1.0f / 64.0f) + LN_EPS);
                unsigned wv[8];
#pragma unroll
                for (int i = 0; i < 8; ++i) wv[i] = pk2(v[2 * i] * rstd * gg[2 * i] * sigmoid_f(og[2 * i]), v[2 * i + 1] * rstd * gg[2 * i + 1] * sigmoid_f(og[2 * i + 1]));
                bf16_t* yp = Y + rows[r] * DM + h * 64 + seg * 16;
                *(u32x4*)yp = (u32x4){wv[0], wv[1], wv[2], wv[3]}; *(u32x4*)(yp + 8) = (u32x4){wv[4], wv[5], wv[6], wv[7]}; }
        }
    }
}

#ifndef PHM
#define PHM 63
#endif
__device__ __forceinline__ unsigned xcc_id() { return (unsigned)__builtin_amdgcn_s_getreg((3 << 11) | 20) & 7u; }
__device__ __forceinline__ void mixer_phase(const Params& p, int l, bool last, LAS unsigned char* lds) {
    unsigned* ctr = (unsigned*)(p.ws + WS_CTL) + 64 * (l + 1);
    LAS int* slot = (LAS int*)(lds + LDS_BYTES - 16);
    const int nper = last ? 132 : 140;
    int q = (int)xcc_id(), tried = 0;
    for (;;) {
        if (threadIdx.x == 0) {
            int it = -1;
            while (tried < 8) { const int v = (int)atomicAdd(ctr + q, 1u); if (v < nper) { it = (q << 8) | v; break; } q = (q + 1) & 7; ++tried; }
            *slot = it;
        }
        __syncthreads();
        const int code = *slot;
        __syncthreads();
        if (code < 0) break;
        const int x = code >> 8; int it = code & 255;
        if (it < 4) { const int m = x * 4 + it; if (PHM & 1) mlstm_unit(p, l, m >> 2, m & 3, lds); }
        else if ((it -= 4) < 64) { const int pr = x + 8 * (it >> 4); if (PHM & 2) diff_unit(p, l, pr >> 2, pr & 3, it & 15, false, lds); }
        else if ((it -= 64) < 64) { const int k = x + 8 * (it >> 5); if (PHM & 4) gqa_unit(p, k >> 1, (k & 1) * 2 + ((it >> 4) & 1), it & 15, false, lds); }
        else if ((it -= 64) < 4) { const int pr = x + 8 * it; if (PHM & 2) diff_unit(p, l, pr >> 2, pr & 3, 0, true, lds); }
        else { it -= 4; const int idx = x + 8 * it; if (PHM & 4) gqa_unit(p, idx >> 2, idx & 3, 0, true, lds); }
        __syncthreads();
    }
    if (!last) wconv_dyn(p, l + 1, 15, (unsigned*)(p.ws + WS_CTL) + 620 + l, lds);
}

__device__ __forceinline__ void ln_ctx_phase(const Params& p, int l, bool last, int which, const bf16_t* A, const bf16_t* Bt, int K, bf16_t* O, const float* gmod, const float* lng, const float* lnb,
                                             const float* nmod, float* outp, unsigned* ctl, LAS unsigned char* lds, const float* xin_lat = nullptr, const float* xin_ctx = nullptr) {
    int tid_ = threadIdx.x; asm volatile("" : "+v"(tid_));
    const int lane = tid_ & 63, wave = tid_ >> 6;
    if (last) { ln_rows(p, O, gmod, lng, lnb, nmod, outp, lane, blockIdx.x * 8 + wave, gridDim.x * 8, MLAT, xin_lat, xin_ctx); return; }
    if (blockIdx.x < 32) {
        const int pm = 128 + ((int)blockIdx.x >> 2), pn = (int)blockIdx.x & 3;
        unsigned* cnt = ctl + 8192 + (l * 2 + which) * 8 + (pm - 128);
        { pg8::Gemm g{A, Bt, MTOT, DM, K}; pg8::SingleOrder S{pm, pn, cnt}; pg8::EpiPlain E{O, DM};
          pg8::gemm_phase<pg8::EpiPlain, pg8::SingleOrder, true, true>(lds, g, S, E); }
        if (tid_ == 0) { while (__hip_atomic_load(cnt, __ATOMIC_RELAXED, __HIP_MEMORY_SCOPE_AGENT) < 32u) __builtin_amdgcn_s_sleep(8); }
        __syncthreads();
        __builtin_amdgcn_fence(__ATOMIC_ACQUIRE, "agent");
        const int base = pm * 256 + pn * 64 + wave * 8;
        ln_rows(p, O, gmod, lng, lnb, nmod, outp, lane, base, 1, base + 8, xin_lat, xin_ctx);
    } else {
        ln_rows(p, O, gmod, lng, lnb, nmod, outp, lane, ((int)blockIdx.x - 32) * 8 + wave, ((int)gridDim.x - 32) * 8, MLAT, xin_lat, xin_ctx);
    }
}

__global__ void __launch_bounds__(512, 2) fwd_megakernel(Params p) {
    extern __shared__ __attribute__((aligned(16))) unsigned char lds_raw[];
    LAS unsigned char* lds = (LAS unsigned char*)lds_raw;
    cg::grid_group grid = cg::this_grid();
    if (threadIdx.x < 16) ((LAS unsigned*)(lds + LDS_BYTES - 64))[threadIdx.x] = 0u;
    __syncthreads();
    const XcdBarrier xb = xcd_barrier_post((unsigned*)(p.ws + WS_CTL) + 4096, (volatile LAS unsigned*)(lds + LDS_BYTES - 64));
    const float* mod = (const float*)(p.ws + WS_MOD);
    unsigned* ctl = (unsigned*)(p.ws + WS_CTL);
    bf16_t* U = (bf16_t*)((unsigned char*)p.out + DO_U);
    mod_phase(p, lds);
    __syncthreads();
    wconv_phase(p, 0, 15, lds);
    grid.sync();
    init_rows_phase(p);
    xcd_barrier(xb);
    for (int l = 0; l < DEPTH; ++l) {
        const bool last = (l == DEPTH - 1);
        const int Mrows = last ? MLAT : MTOT;
        const float* modl = mod + (size_t)l * 9 * MODW;
        {
            pg8::Gemm g{U, (const bf16_t*)(p.ws + WS_WIN), MTOT, NIN, DM}; pg8::StaticOrder S; S.init(MTOT, NIN, gridDim.x, (int)blockIdx.x);
            pg8::EpiIn E{(bf16_t*)(p.ws + WS_PM), (bf16_t*)(p.ws + WS_MVT), (bf16_t*)(p.ws + WS_QD), (bf16_t*)(p.ws + WS_QDC), (bf16_t*)(p.ws + WS_KD), (bf16_t*)(p.ws + WS_VDT),
                         (bf16_t*)(p.ws + WS_QG), (bf16_t*)(p.ws + WS_QGC), (bf16_t*)(p.ws + WS_KG), (bf16_t*)(p.ws + WS_VGT), (float*)(p.ws + WS_GATES),
                         p.gate_b + l * 16, p.qn_g + l * 64, p.kn_g + l * 64};
            if (PHM & 8) pg8::gemm_phase<pg8::EpiIn, pg8::StaticOrder, true, true>(lds, g, S, E);
        }
        xcd_barrier(xb);
        mixer_phase(p, l, last, lds);
        xcd_barrier(xb);
        {
            pg8::Gemm g{(const bf16_t*)(p.ws + WS_Y), (const bf16_t*)(p.ws + ((l & 1) ? WS_WOUTB : WS_WOUT)), MLAT, DM, DM}; pg8::StaticOrder S; S.init(MLAT, DM, gridDim.x, (int)blockIdx.x);
            pg8::EpiPlain E{(bf16_t*)(p.ws + WS_O1), DM};
            if (PHM & 32) pg8::gemm_phase<pg8::EpiPlain, pg8::StaticOrder, true, true>(lds, g, S, E);
        }
        xcd_barrier(xb);
        ln_ctx_phase(p, l, last, 0, (const bf16_t*)(p.ws + WS_Y), (const bf16_t*)(p.ws + ((l & 1) ? WS_WOUTB : WS_WOUT)), DM, (bf16_t*)(p.ws + WS_O1), modl + 2048, p.ln1_g + l * DM, p.ln1_b + l * DM, modl + 3072, nullptr, ctl, lds, l == 0 ? p.x : nullptr, l == 0 ? p.ctx : nullptr);
        xcd_barrier(xb);
        {
            pg8::Gemm g{U, (l & 1) ? (const bf16_t*)((unsigned char*)p.out + DO_WF1B) : (const bf16_t*)(p.ws + WS_WF1), Mrows, NF1, DM}; pg8::StaticOrder S; S.init(Mrows, NF1, gridDim.x, (int)blockIdx.x);
            pg8::EpiSwiglu E{(bf16_t*)(p.ws + WS_H)};
            if (PHM & 16) pg8::gemm_phase<pg8::EpiSwiglu, pg8::StaticOrder, true, true>(lds, g, S, E);
        }
        xcd_barrier(xb);
        {
            pg8::Gemm g{(const bf16_t*)(p.ws + WS_H), (const bf16_t*)(p.ws + ((l & 1) ? WS_WF2B : WS_WF2)), MLAT, DM, DFF}; pg8::StaticOrder S; S.init(MLAT, DM, gridDim.x, (int)blockIdx.x);
            pg8::EpiPlain E{(bf16_t*)(p.ws + WS_O2), DM};
            if (PHM & 32) pg8::gemm_phase<pg8::EpiPlain, pg8::StaticOrder, true, true>(lds, g, S, E);
        }
        xcd_barrier(xb);
        ln_ctx_phase(p, l, last, 1, (const bf16_t*)(p.ws + WS_H), (const bf16_t*)(p.ws + ((l & 1) ? WS_WF2B : WS_WF2)), DFF, (bf16_t*)(p.ws + WS_O2), modl + 5120, p.ln2_g + l * DM, p.ln2_b + l * DM, last ? nullptr : (modl + 9 * MODW), last ? p.out : nullptr, ctl, lds);
        if (!last) { xcd_barrier(xb); }
    }
}

extern "C" void kernel_launch(void* const* d_in, const int* in_sizes, int n_in, void* d_out, int out_size, void* d_ws, size_t ws_size, hipStream_t stream) {
    static int grid = 0;
    if (grid == 0) {
        if (n_in != 22 || out_size != MLAT * DM || ws_size < WS_END) { fprintf(stderr, "kernel_launch: unexpected shapes (n_in %d, out %d, ws %zu)\n", n_in, out_size, ws_size); grid = -1; return; }
        int dev = 0, cus = 0, per_cu = 0;
        hipGetDevice(&dev); hipDeviceGetAttribute(&cus, hipDeviceAttributeMultiprocessorCount, dev);
        if (hipFuncSetAttribute((const void*)fwd_megakernel, hipFuncAttributeMaxDynamicSharedMemorySize, LDS_BYTES) != hipSuccess) { fprintf(stderr, "kernel_launch: hipFuncSetAttribute failed\n"); grid = -1; return; }
        if (hipOccupancyMaxActiveBlocksPerMultiprocessor(&per_cu, (const void*)fwd_megakernel, 512, LDS_BYTES) != hipSuccess || per_cu < 1) { fprintf(stderr, "kernel_launch: occupancy query says %d\n", per_cu); per_cu = 1; }
        (void)hipGetLastError();
        grid = cus * 1;
    }
    if (grid < 0) return;
    hipMemsetAsync((char*)d_ws + WS_CTL, 0, 65536, stream);
    Params p{};
    const float** f = (const float**)&p;
    for (int i = 0; i < 22; ++i) f[i] = (const float*)d_in[i];
    p.out = (float*)d_out; p.ws = (unsigned char*)d_ws;
    void* args[] = {&p};
    hipError_t e = hipLaunchCooperativeKernel((const void*)fwd_megakernel, dim3(grid), dim3(512), args, LDS_BYTES, stream);
    if (e != hipSuccess) fprintf(stderr, "cooperative launch failed: %s (grid %d)\n", hipGetErrorString(e), grid);
}
```
